# Optimizing an MI355X kernel written in HIP

```python
import math
import jax
import jax.numpy as jnp
from jax import lax
import numpy as np

D_MODEL = 1024
BATCH = 8
SEQ = 2048
DEPTH = 4

N_MIXERS = 3
RMS_EPS = 1e-6
LRU_WIDTH = D_MODEL
LRU_BLOCKS = 8
LRU_BLOCK_W = LRU_WIDTH // LRU_BLOCKS
CONV_WIDTH = 4
LRU_C = 8.0
POOL_WINDOWS = (2, 4, 8, 16)
POOL_GROUPS = len(POOL_WINDOWS)
POOL_GROUP_W = D_MODEL // POOL_GROUPS
SB_HEADS = 16
SB_HEAD_DIM = D_MODEL // SB_HEADS
SB_BLOCK = 128
N_EXPERTS = 32
TOP_K = 4
D_EXPERT = D_MODEL
SWIGLU_LIMIT = 7.0
SWIGLU_ALPHA = 1.702
MOE_BLOCK = 256
N_LRU_LAYERS = len(range(0, DEPTH, N_MIXERS))
N_POOL_LAYERS = len(range(1, DEPTH, N_MIXERS))
N_SB_LAYERS = len(range(2, DEPTH, N_MIXERS))

kernel_name = 'hybrid_lru_pool_stickbreak_moe'


def rms_norm(x, g):
    xf = x.astype(jnp.float32)
    y = xf * lax.rsqrt(jnp.mean(xf * xf, axis=-1, keepdims=True) + RMS_EPS)
    return (y * g.astype(jnp.float32)).astype(x.dtype)


def causal_depthwise_conv(x, w, b):
    k_w = w.shape[0]
    s = x.shape[1]
    xp = jnp.pad(x, ((0, 0), (k_w - 1, 0), (0, 0)))
    y = b
    for k in range(k_w):
        y = y + xp[:, k:k + s] * w[k]
    return y


def block_diag_linear(x, w, b):
    g, cg, _ = w.shape
    xg = x.reshape(x.shape[:-1] + (g, cg))
    return jnp.einsum('bsgi,gio->bsgo', xg, w).reshape(x.shape) + b


def rg_lru(x, w_a, b_a, w_x, b_x, a_param):
    xf = x.astype(jnp.float32)
    r = jax.nn.sigmoid(block_diag_linear(x, w_a, b_a).astype(jnp.float32))
    i = jax.nn.sigmoid(block_diag_linear(x, w_x, b_x).astype(jnp.float32))
    log_a = -LRU_C * r * jax.nn.softplus(-a_param.astype(jnp.float32))
    a = jnp.exp(log_a)
    b_in = jnp.sqrt(-jnp.expm1(2.0 * log_a)) * (i * xf)

    def combine(left, right):
        a_l, b_l = left
        a_r, b_r = right
        return a_l * a_r, a_r * b_l + b_r

    _, h = lax.associative_scan(combine, (a, b_in), axis=1)
    return h.astype(x.dtype)


def lru_mixer(u, w_in, conv_w, conv_b, w_a, b_a, w_x, b_x, a_param, w_out):
    proj = u @ w_in
    gate, xb = proj[..., :LRU_WIDTH], proj[..., LRU_WIDTH:]
    xb = causal_depthwise_conv(xb, conv_w, conv_b)
    y = rg_lru(xb, w_a, b_a, w_x, b_x, a_param)
    y = y * jax.nn.gelu(gate)
    return y @ w_out


def pool_mixer(u, w_in, w_group, scale, w_out):
    v = u @ w_in
    vf = v.astype(jnp.float32)
    s = v.shape[1]
    csum = jnp.cumsum(vf, axis=1)
    n_avail = jnp.arange(1, s + 1, dtype=jnp.float32)[None, :, None]
    outs = []
    for g, win in enumerate(POOL_WINDOWS):
        lo, hi = g * POOL_GROUP_W, (g + 1) * POOL_GROUP_W
        c = csum[..., lo:hi]
        lag = jnp.pad(c, ((0, 0), (win, 0), (0, 0)))[:, :s]
        mean = (c - lag) / jnp.minimum(n_avail, float(win))
        outs.append(mean - vf[..., lo:hi])
    pooled = jnp.concatenate(outs, axis=-1).astype(v.dtype)
    pg = pooled.reshape(pooled.shape[:-1] + (POOL_GROUPS, POOL_GROUP_W))
    mixed = jnp.einsum('bsgi,gio->bsgo', pg, w_group).reshape(pooled.shape)
    return (mixed * scale) @ w_out


def stick_breaking_attention(q, k, v):
    s = q.shape[2]
    scale = 1.0 / math.sqrt(q.shape[-1])
    outs = []
    for blk in range(s // SB_BLOCK):
        q0 = blk * SB_BLOCK
        kv_len = q0 + SB_BLOCK
        q_b = q[:, :, q0:q0 + SB_BLOCK]
        k_b = k[:, :, :kv_len]
        v_b = v[:, :, :kv_len]
        z = jnp.einsum('bhqd,bhkd->bhqk', q_b, k_b).astype(jnp.float32) * scale
        t_pos = q0 + jnp.arange(SB_BLOCK)[:, None]
        s_pos = jnp.arange(kv_len)[None, :]
        mask = s_pos < t_pos
        log_1m = jnp.where(mask, jax.nn.log_sigmoid(-z), 0.0)
        suffix = lax.cumsum(log_1m, axis=3, reverse=True) - log_1m
        a = jnp.where(mask, jnp.exp(jax.nn.log_sigmoid(z) + suffix), 0.0)
        outs.append(jnp.einsum('bhqk,bhkd->bhqd', a.astype(v.dtype), v_b))
    return jnp.concatenate(outs, axis=2)


def sb_mixer(u, w_qkv, w_out):
    b, s, d = u.shape
    qkv = (u @ w_qkv).reshape(b, s, 3, SB_HEADS, SB_HEAD_DIM)
    qkv = qkv.transpose(2, 0, 3, 1, 4)
    o = stick_breaking_attention(qkv[0], qkv[1], qkv[2])
    o = o.transpose(0, 2, 1, 3).reshape(b, s, d)
    return o @ w_out


def moe(x2d, w_router, b_router, w_gate_up, b_gate_up, w_down, b_down):
    t, d = x2d.shape
    logits = (x2d @ w_router + b_router).astype(jnp.float32)
    top_vals, top_idx = lax.top_k(logits, TOP_K)
    gates = jax.nn.softmax(top_vals, axis=-1)
    tk = t * TOP_K
    flat_e = top_idx.reshape(-1).astype(jnp.int32)
    flat_tok = jnp.repeat(jnp.arange(t, dtype=jnp.int32), TOP_K)
    flat_gate = gates.reshape(-1)
    order = jnp.argsort(flat_e)
    sorted_e = flat_e[order]
    sorted_tok = flat_tok[order]
    sorted_gate = flat_gate[order]
    counts = jnp.bincount(flat_e, length=N_EXPERTS).astype(jnp.int32)
    starts = jnp.cumsum(counts) - counts
    padded_counts = (counts + MOE_BLOCK - 1) // MOE_BLOCK * MOE_BLOCK
    padded_ends = jnp.cumsum(padded_counts)
    padded_starts = padded_ends - padded_counts
    dest = padded_starts[sorted_e] + (jnp.arange(tk, dtype=jnp.int32) - starts[sorted_e])
    n_blocks = -(-tk // MOE_BLOCK) + N_EXPERTS
    n_slots = n_blocks * MOE_BLOCK
    slot_tok = jnp.zeros((n_slots,), jnp.int32).at[dest].set(sorted_tok)
    slot_gate = jnp.zeros((n_slots,), jnp.float32).at[dest].set(sorted_gate)
    block_starts = jnp.arange(n_blocks, dtype=jnp.int32) * MOE_BLOCK
    block_expert = jnp.minimum(jnp.searchsorted(padded_ends, block_starts, side='right'),
                               N_EXPERTS - 1).astype(jnp.int32)
    xs = x2d[slot_tok].reshape(n_blocks, MOE_BLOCK, d)

    def expert_block(args):
        xb, e = args
        gu = xb @ w_gate_up[e] + b_gate_up[e]
        gate = jnp.minimum(gu[..., :D_EXPERT], SWIGLU_LIMIT)
        up = jnp.clip(gu[..., D_EXPERT:], -SWIGLU_LIMIT, SWIGLU_LIMIT)
        glu = gate * jax.nn.sigmoid(gate * SWIGLU_ALPHA)
        return ((up + 1.0) * glu) @ w_down[e] + b_down[e]

    ys = lax.map(expert_block, (xs, block_expert)).reshape(n_slots, d)
    out = jnp.zeros((t, d), jnp.float32).at[slot_tok].add(ys.astype(jnp.float32) * slot_gate[:, None])
    return out.astype(x2d.dtype)


def setup_inputs(seed: int = 0) -> dict:
    key = jax.random.key(seed)
    ks = jax.random.split(key, 32)

    def nrm(i, shape, scale):
        return jax.random.normal(ks[i], shape, jnp.float32) * scale

    d, w, f, e = D_MODEL, LRU_WIDTH, D_EXPERT, N_EXPERTS
    out_scale = (2 * DEPTH) ** -0.5
    a0 = jax.random.uniform(ks[31], (N_LRU_LAYERS, w), jnp.float32, 0.9, 0.999)
    return {
        'x': nrm(0, (BATCH, SEQ, d), 1.0),
        'mix_norm': 1.0 + nrm(1, (DEPTH, d), 0.02),
        'ffn_norm': 1.0 + nrm(2, (DEPTH, d), 0.02),
        'final_norm': 1.0 + nrm(3, (d,), 0.02),
        'lru_w_in': nrm(4, (N_LRU_LAYERS, d, 2 * w), d ** -0.5),
        'lru_conv_w': nrm(5, (N_LRU_LAYERS, CONV_WIDTH, w), CONV_WIDTH ** -0.5),
        'lru_conv_b': nrm(6, (N_LRU_LAYERS, w), 0.01),
        'lru_w_a': nrm(7, (N_LRU_LAYERS, LRU_BLOCKS, LRU_BLOCK_W, LRU_BLOCK_W), LRU_BLOCK_W ** -0.5),
        'lru_b_a': nrm(8, (N_LRU_LAYERS, w), 0.01),
        'lru_w_x': nrm(9, (N_LRU_LAYERS, LRU_BLOCKS, LRU_BLOCK_W, LRU_BLOCK_W), LRU_BLOCK_W ** -0.5),
        'lru_b_x': nrm(10, (N_LRU_LAYERS, w), 0.01),
        'lru_a_param': jnp.log(a0) - jnp.log1p(-a0),
        'lru_w_out': nrm(11, (N_LRU_LAYERS, w, d), w ** -0.5 * out_scale),
        'pool_w_in': nrm(12, (N_POOL_LAYERS, d, d), d ** -0.5),
        'pool_w_group': nrm(13, (N_POOL_LAYERS, POOL_GROUPS, POOL_GROUP_W, POOL_GROUP_W), POOL_GROUP_W ** -0.5),
        'pool_scale': 1.0 + nrm(14, (N_POOL_LAYERS, d), 0.1),
        'pool_w_out': nrm(15, (N_POOL_LAYERS, d, d), d ** -0.5 * out_scale),
        'sb_w_qkv': nrm(16, (N_SB_LAYERS, d, 3 * d), d ** -0.5),
        'sb_w_out': nrm(17, (N_SB_LAYERS, d, d), d ** -0.5 * out_scale),
        'moe_w_router': nrm(18, (DEPTH, d, e), d ** -0.5),
        'moe_b_router': nrm(19, (DEPTH, e), 0.01),
        'moe_w_gate_up': nrm(20, (DEPTH, e, d, 2 * f), d ** -0.5),
        'moe_b_gate_up': nrm(21, (DEPTH, e, 2 * f), 0.01),
        'moe_w_down': nrm(22, (DEPTH, e, f, d), f ** -0.5 * out_scale),
        'moe_b_down': nrm(23, (DEPTH, e, d), 0.01),
    }


def reference(x, mix_norm, ffn_norm, final_norm,
              lru_w_in, lru_conv_w, lru_conv_b, lru_w_a, lru_b_a, lru_w_x, lru_b_x,
              lru_a_param, lru_w_out,
              pool_w_in, pool_w_group, pool_scale, pool_w_out,
              sb_w_qkv, sb_w_out,
              moe_w_router, moe_b_router, moe_w_gate_up, moe_b_gate_up, moe_w_down, moe_b_down):
    b, s, d = x.shape
    h = x
    for layer in range(DEPTH):
        kind = layer % N_MIXERS
        slot = layer // N_MIXERS
        u = rms_norm(h, mix_norm[layer])
        if kind == 0:
            m = lru_mixer(u, lru_w_in[slot], lru_conv_w[slot], lru_conv_b[slot],
                          lru_w_a[slot], lru_b_a[slot], lru_w_x[slot], lru_b_x[slot],
                          lru_a_param[slot], lru_w_out[slot])
        elif kind == 1:
            m = pool_mixer(u, pool_w_in[slot], pool_w_group[slot], pool_scale[slot], pool_w_out[slot])
        else:
            m = sb_mixer(u, sb_w_qkv[slot], sb_w_out[slot])
        h = h + m
        u = rms_norm(h, ffn_norm[layer]).reshape(b * s, d)
        h = h + moe(u, moe_w_router[layer], moe_b_router[layer], moe_w_gate_up[layer],
                    moe_b_gate_up[layer], moe_w_down[layer], moe_b_down[layer]).reshape(b, s, d)
    return rms_norm(h, final_norm)
```

```cpp
#include <hip/hip_runtime.h>
#include <stdint.h>

typedef unsigned short bf16_t;
typedef short bf16x8 __attribute__((ext_vector_type(8)));
typedef float f32x16 __attribute__((ext_vector_type(16)));
typedef float f32x4 __attribute__((ext_vector_type(4)));
typedef float f32x2_t __attribute__((ext_vector_type(2)));
typedef __bf16 bf16x2_t __attribute__((ext_vector_type(2)));
typedef unsigned u32x4 __attribute__((ext_vector_type(4)));
typedef unsigned u32x2 __attribute__((ext_vector_type(2)));

constexpr int T_TOK = 16384, DM = 1024, SEQ = 2048, NB = 8, NE = 32, TOPK = 4, NH = 16, HD = 64;
constexpr int ECAP = 16384;
constexpr int PADROWS = 65536 + 32 * 256;
constexpr float RMS_EPS = 1e-6f;

constexpr size_t MB = 1024ull * 1024ull;
constexpr size_t WS_CTL = 0;
constexpr size_t WS_LIST = 1 * MB;
constexpr size_t WS_TOKSLOT = 3 * MB;
constexpr size_t WS_GATES = 4 * MB;
constexpr size_t WS_H = 8 * MB;
constexpr size_t WS_U = WS_H + 64 * MB;
constexpr size_t WS_B0 = WS_U + 32 * MB;
constexpr size_t WS_B1 = WS_B0 + 32 * MB;
constexpr size_t WS_B2 = WS_B1 + 32 * MB;
constexpr size_t WS_B3 = WS_B2 + 32 * MB;
constexpr size_t WS_ACT = WS_B3 + 32 * MB;
constexpr size_t WS_YS = WS_ACT + 160 * MB;
constexpr size_t WS_W = WS_YS + 160 * MB;
constexpr size_t WT_LRU_IN = WS_W;
constexpr size_t WT_LRU_OUT = WT_LRU_IN + 8 * MB;
constexpr size_t WT_POOL_IN = WT_LRU_OUT + 4 * MB;
constexpr size_t WT_POOL_G = WT_POOL_IN + 2 * MB;
constexpr size_t WT_POOL_OUT = WT_POOL_G + 1 * MB;
constexpr size_t WT_QKV = WT_POOL_OUT + 2 * MB;
constexpr size_t WT_SB_OUT = WT_QKV + 6 * MB;
constexpr size_t WT_LRU_A = WT_SB_OUT + 2 * MB;
constexpr size_t WT_LRU_X = WT_LRU_A + 1 * MB;
constexpr size_t WT_GU = WT_LRU_X + 1 * MB;
constexpr size_t WT_DN = WT_GU + 512 * MB;
constexpr size_t WS_END = WT_DN + 256 * MB;
constexpr int CW_CNT = 8192;

struct Params {
    const float* in[25];
    float* out;
    unsigned char* ws;
};
enum { I_X = 0, I_MIXN, I_FFNN, I_FINN, I_LRU_WIN, I_LRU_CW, I_LRU_CB, I_LRU_WA, I_LRU_BA, I_LRU_WX, I_LRU_BX, I_LRU_AP, I_LRU_WOUT,
       I_POOL_WIN, I_POOL_WG, I_POOL_SC, I_POOL_WOUT, I_SB_WQKV, I_SB_WOUT, I_MOE_WR, I_MOE_BR, I_MOE_WGU, I_MOE_BGU, I_MOE_WDN, I_MOE_BDN };

__device__ __forceinline__ float bf2f(bf16_t b) { return __uint_as_float(((unsigned)b) << 16); }
__device__ __forceinline__ unsigned pk2(float lo, float hi) { f32x2_t v = {lo, hi}; bf16x2_t b = __builtin_convertvector(v, bf16x2_t); return __builtin_bit_cast(unsigned, b); }
__device__ __forceinline__ bf16_t f2bf(float f) { return (bf16_t)(pk2(f, 0.f) & 0xffffu); }
__device__ __forceinline__ int crow(int r, int hi) { return (r & 3) + 8 * (r >> 2) + 4 * hi; }
__device__ __forceinline__ float wave_sum(float v) {
#pragma unroll
    for (int o = 32; o >= 1; o >>= 1) v += __shfl_xor(v, o);
    return v;
}
__device__ __forceinline__ float sigmoidf_(float x) { return 1.0f / (1.0f + __expf(-x)); }
__device__ __forceinline__ float gelu_tanh(float x) {
    const float y = 0.7978845608028654f * (x + 0.044715f * x * x * x);
    return x / (1.0f + __expf(-2.0f * y));
}

__device__ __forceinline__ void convT_unit(const float* __restrict__ src, bf16_t* __restrict__ dst, int K, int N, int k0, int n0, unsigned char* lds) {
    const int tid = threadIdx.x, lane = tid & 63, kg = tid >> 6;
    f32x4 v[8];
#pragma unroll
    for (int j = 0; j < 8; ++j) v[j] = *(const f32x4*)(src + (size_t)(k0 + kg * 8 + j) * N + n0 + lane * 4);
#pragma unroll
    for (int i = 0; i < 4; ++i) {
        u32x4 w;
        w.x = pk2(v[0][i], v[1][i]); w.y = pk2(v[2][i], v[3][i]); w.z = pk2(v[4][i], v[5][i]); w.w = pk2(v[6][i], v[7][i]);
        *(u32x4*)(lds + (lane * 4 + i) * 144 + kg * 16) = w;
    }
    __syncthreads();
#pragma unroll
    for (int p = 0; p < 4; ++p) {
        const int n = p * 64 + (tid >> 3), ch = tid & 7;
        const u32x4 w = *(const u32x4*)(lds + n * 144 + ch * 16);
        *(u32x4*)(dst + (size_t)(n0 + n) * K + k0 + ch * 8) = w;
    }
    __syncthreads();
}
__device__ __forceinline__ void convT_job(const float* src, bf16_t* dst, int nbat, int K, int N, unsigned char* lds, int bid, int nblk) {
    const int kt = K / 64, ntl = N / 256, per = kt * ntl, total = nbat * per;
    for (int u = bid; u < total; u += nblk) {
        const int m = u / per, r = u % per, ki = r / ntl, ni = r % ntl;
        convT_unit(src + (size_t)m * K * N, dst + (size_t)m * K * N, K, N, ki * 64, ni * 256, lds);
    }
}
__device__ __forceinline__ void convT_small(const float* src, bf16_t* dst, int nbat, int K, int N, int bid, int nblk) {
    const size_t total = (size_t)nbat * K * N;
    for (size_t i = (size_t)bid * blockDim.x + threadIdx.x; i < total; i += (size_t)nblk * blockDim.x) {
        const size_t m = i / ((size_t)K * N), r = i % ((size_t)K * N);
        const int n = (int)(r / K), k = (int)(r % K);
        dst[i] = f2bf(src[m * K * N + (size_t)k * N + n]);
    }
}

__device__ __forceinline__ void norm_row_wave(const float* __restrict__ xrow, const float* __restrict__ g, bf16_t* __restrict__ orow, int lane) {
    f32x4 v[4]; float ss = 0.f;
#pragma unroll
    for (int j = 0; j < 4; ++j) { v[j] = *(const f32x4*)(xrow + j * 256 + lane * 4); ss += v[j][0] * v[j][0] + v[j][1] * v[j][1] + v[j][2] * v[j][2] + v[j][3] * v[j][3]; }
    ss = wave_sum(ss);
    const float rstd = rsqrtf(ss * (1.0f / 1024.0f) + RMS_EPS);
#pragma unroll
    for (int j = 0; j < 4; ++j) {
        const f32x4 gg = *(const f32x4*)(g + j * 256 + lane * 4);
        u32x2 w; w.x = pk2(v[j][0] * rstd * gg[0], v[j][1] * rstd * gg[1]); w.y = pk2(v[j][2] * rstd * gg[2], v[j][3] * rstd * gg[3]);
        *(u32x2*)(orow + j * 256 + lane * 4) = w;
    }
}

__device__ void phase_prep(const Params& p, unsigned char* lds, int bid, int nblk) {
    unsigned char* ws = p.ws;
    convT_job(p.in[I_LRU_WIN], (bf16_t*)(ws + WT_LRU_IN), 2, 1024, 2048, lds, bid, nblk);
    convT_job(p.in[I_LRU_WOUT], (bf16_t*)(ws + WT_LRU_OUT), 2, 1024, 1024, lds, bid, nblk);
    convT_job(p.in[I_POOL_WIN], (bf16_t*)(ws + WT_POOL_IN), 1, 1024, 1024, lds, bid, nblk);
    convT_job(p.in[I_POOL_WG], (bf16_t*)(ws + WT_POOL_G), 4, 256, 256, lds, bid, nblk);
    convT_job(p.in[I_POOL_WOUT], (bf16_t*)(ws + WT_POOL_OUT), 1, 1024, 1024, lds, bid, nblk);
    convT_job(p.in[I_SB_WQKV], (bf16_t*)(ws + WT_QKV), 1, 1024, 3072, lds, bid, nblk);
    convT_job(p.in[I_SB_WOUT], (bf16_t*)(ws + WT_SB_OUT), 1, 1024, 1024, lds, bid, nblk);
    convT_job(p.in[I_MOE_WGU], (bf16_t*)(ws + WT_GU), 128, 1024, 2048, lds, bid, nblk);
    convT_job(p.in[I_MOE_WDN], (bf16_t*)(ws + WT_DN), 128, 1024, 1024, lds, bid, nblk);
    convT_small(p.in[I_LRU_WA], (bf16_t*)(ws + WT_LRU_A), 16, 128, 128, bid, nblk);
    convT_small(p.in[I_LRU_WX], (bf16_t*)(ws + WT_LRU_X), 16, 128, 128, bid, nblk);
    const int wid = threadIdx.x >> 6, lane = threadIdx.x & 63, nw = blockDim.x >> 6;
    for (int t = bid * nw + wid; t < T_TOK; t += nblk * nw)
        norm_row_wave(p.in[I_X] + (size_t)t * DM, p.in[I_MIXN], (bf16_t*)(ws + WS_U) + (size_t)t * DM, lane);
}

struct RowId { __device__ __forceinline__ size_t operator()(int m) const { return (size_t)m; } };
template <class RM, class Epi>
__device__ __forceinline__ void gemm_simple(const bf16_t* __restrict__ A, int lda, const bf16_t* __restrict__ Bt, int ldb, int Mt, int Nt, int K, const RM& rm, const Epi& epi, int bid, int nblk) {
    const int wid = threadIdx.x >> 6, lane = threadIdx.x & 63, r32 = lane & 31, hi = lane >> 5, nw = blockDim.x >> 6;
    const long total = (long)Mt * Nt;
    for (long tile = (long)bid * nw + wid; tile < total; tile += (long)nblk * nw) {
        const int tm = (int)(tile / Nt), tn = (int)(tile % Nt);
        const bf16_t* ap = A + rm(tm * 32 + r32) * lda + hi * 8;
        const bf16_t* bp = Bt + (size_t)(tn * 32 + r32) * ldb + hi * 8;
        f32x16 acc = {};
        for (int k = 0; k < K; k += 16) {
            const bf16x8 a = *(const bf16x8*)(ap + k);
            const bf16x8 b = *(const bf16x8*)(bp + k);
            acc = __builtin_amdgcn_mfma_f32_32x32x16_bf16(a, b, acc, 0, 0, 0);
        }
#pragma unroll
        for (int r = 0; r < 16; ++r) epi(tm * 32 + crow(r, hi), tn * 32 + r32, acc[r]);
    }
}

struct EpiLruIn { bf16_t* gg; bf16_t* xbp;
    __device__ __forceinline__ void operator()(int m, int n, float v) const {
        if (n < 1024) gg[(size_t)m * DM + n] = f2bf(gelu_tanh(v)); else xbp[(size_t)m * DM + n - 1024] = f2bf(v); } };
struct EpiF32 { float* o; int ld; int coff;
    __device__ __forceinline__ void operator()(int m, int n, float v) const { o[(size_t)m * ld + coff + n] = v; } };
struct EpiResid { const float* hin; float* hout;
    __device__ __forceinline__ void operator()(int m, int n, float v) const { hout[(size_t)m * DM + n] = hin[(size_t)m * DM + n] + v; } };
struct EpiBf16 { bf16_t* o; int ld; int coff;
    __device__ __forceinline__ void operator()(int m, int n, float v) const { o[(size_t)m * ld + coff + n] = f2bf(v); } };
struct EpiBf16Scale { bf16_t* o; int ld; int coff; const float* sc;
    __device__ __forceinline__ void operator()(int m, int n, float v) const { o[(size_t)m * ld + coff + n] = f2bf(v * sc[coff + n]); } };
struct EpiQKV { bf16_t* q; bf16_t* k; bf16_t* v; float qs;
    __device__ __forceinline__ void operator()(int m, int n, float x) const {
        if (n < 1024) q[(size_t)m * DM + n] = f2bf(x * qs); else if (n < 2048) k[(size_t)m * DM + n - 1024] = f2bf(x); else v[(size_t)m * DM + n - 2048] = f2bf(x); } };

__device__ __forceinline__ float conv_at(const bf16_t* xbp, const float* cw, const float* cb, int t, int c) {
    const int pos = t & (SEQ - 1);
    float y = cb[c];
#pragma unroll
    for (int k = 0; k < 4; ++k) { const int pp = pos - 3 + k; if (pp >= 0) y += bf2f(xbp[(size_t)(t - 3 + k) * DM + c]) * cw[k * DM + c]; }
    return y;
}
__device__ void phase_lru_conv(const Params& p, int slot, int bid, int nblk) {
    const bf16_t* xbp = (const bf16_t*)(p.ws + WS_B1); bf16_t* xbc = (bf16_t*)(p.ws + WS_B2);
    const float* cw = p.in[I_LRU_CW] + (size_t)slot * 4 * DM; const float* cb = p.in[I_LRU_CB] + (size_t)slot * DM;
    for (size_t i = (size_t)bid * blockDim.x + threadIdx.x; i < (size_t)T_TOK * DM; i += (size_t)nblk * blockDim.x) {
        const int t = (int)(i >> 10), c = (int)(i & 1023);
        xbc[i] = f2bf(conv_at(xbp, cw, cb, t, c));
    }
}
__device__ void phase_lru_scan(const Params& p, int slot, int bid, int nblk) {
    const bf16_t* xbp = (const bf16_t*)(p.ws + WS_B1); const bf16_t* gg = (const bf16_t*)(p.ws + WS_B0); bf16_t* y = (bf16_t*)(p.ws + WS_B3);
    const float* ra = (const float*)(p.ws + WS_ACT); const float* ix = (const float*)(p.ws + WS_YS);
    const float* cw = p.in[I_LRU_CW] + (size_t)slot * 4 * DM; const float* cb = p.in[I_LRU_CB] + (size_t)slot * DM;
    const float* ba = p.in[I_LRU_BA] + (size_t)slot * DM; const float* bx = p.in[I_LRU_BX] + (size_t)slot * DM; const float* ap = p.in[I_LRU_AP] + (size_t)slot * DM;
    for (int i = bid * blockDim.x + threadIdx.x; i < NB * DM; i += nblk * blockDim.x) {
        const int b = i >> 10, c = i & 1023;
        const float ca = -8.0f * log1pf(__expf(-ap[c]));
        float h = 0.f;
        for (int s = 0; s < SEQ; ++s) {
            const int t = b * SEQ + s; const size_t o = (size_t)t * DM + c;
            const float r = sigmoidf_(ra[o] + ba[c]), ii = sigmoidf_(ix[o] + bx[c]);
            const float la = ca * r, a = __expf(la);
            const float xb = conv_at(xbp, cw, cb, t, c);
            const float bin = sqrtf(fmaxf(1.0f - a * a, 0.f)) * (ii * xb);
            h = a * h + bin;
            y[o] = f2bf(h * bf2f(gg[o]));
        }
    }
}

__device__ void phase_pool_pool(const Params& p, int bid, int nblk) {
    const bf16_t* v = (const bf16_t*)(p.ws + WS_B0); bf16_t* pb = (bf16_t*)(p.ws + WS_B1);
    for (size_t i = (size_t)bid * blockDim.x + threadIdx.x; i < (size_t)T_TOK * DM; i += (size_t)nblk * blockDim.x) {
        const int t = (int)(i >> 10), c = (int)(i & 1023), pos = t & (SEQ - 1), g = c >> 8;
        const int win = 2 << g;
        const int n = pos + 1 < win ? pos + 1 : win;
        float s = 0.f;
        for (int j = 0; j < n; ++j) s += bf2f(v[(size_t)(t - j) * DM + c]);
        pb[i] = f2bf(s / (float)n - bf2f(v[i]));
    }
}

__device__ void phase_sb_attn(const Params& p, int bid, int nblk) {
    const bf16_t* Q = (const bf16_t*)(p.ws + WS_B0); const bf16_t* Kp = (const bf16_t*)(p.ws + WS_B1); const bf16_t* V = (const bf16_t*)(p.ws + WS_B2); bf16_t* O = (bf16_t*)(p.ws + WS_B3);
    for (int i = bid * blockDim.x + threadIdx.x; i < NB * NH * SEQ; i += nblk * blockDim.x) {
        const int t = i & (SEQ - 1), h = (i >> 11) & 15, b = i >> 15;
        const size_t row = (size_t)(b * SEQ + t) * DM + h * HD;
        float q[HD], o[HD];
#pragma unroll
        for (int d = 0; d < HD; ++d) { q[d] = bf2f(Q[row + d]); o[d] = 0.f; }
        float S = 1.0f;
        for (int s = t - 1; s >= 0 && S > 0.f; --s) {
            const size_t kr = (size_t)(b * SEQ + s) * DM + h * HD;
            float z = 0.f;
#pragma unroll
            for (int d = 0; d < HD; ++d) z += q[d] * bf2f(Kp[kr + d]);
            const float e = exp2f(z);
            const float r = 1.0f / (1.0f + e);
            const float Sn = S * r, a = S - Sn;
#pragma unroll
            for (int d = 0; d < HD; ++d) o[d] += a * bf2f(V[kr + d]);
            S = Sn;
        }
#pragma unroll
        for (int d = 0; d < HD; ++d) O[row + d] = f2bf(o[d]);
    }
}

__device__ __forceinline__ void moe_pstart(const int* cnt, int* ps  ) {
    if (threadIdx.x == 0) { int acc = 0; for (int e = 0; e < NE; ++e) { ps[e] = acc; acc += ((cnt[e] + 255) >> 8) << 8; } ps[NE] = acc; }
    __syncthreads();
}
__device__ void phase_moe_route(const Params& p, int layer, int bid, int nblk) {
    const float* H = (const float*)(p.ws + WS_H); bf16_t* U = (bf16_t*)(p.ws + WS_U);
    const float* g = p.in[I_FFNN] + (size_t)layer * DM; const float* wr = p.in[I_MOE_WR] + (size_t)layer * DM * NE; const float* br = p.in[I_MOE_BR] + (size_t)layer * NE;
    int* cnt = (int*)(p.ws + WS_CTL) + CW_CNT + layer * NE; int* list = (int*)(p.ws + WS_LIST); int* tokslot = (int*)(p.ws + WS_TOKSLOT); float* gates = (float*)(p.ws + WS_GATES);
    const int wid = threadIdx.x >> 6, lane = threadIdx.x & 63, nw = blockDim.x >> 6;
    for (int t = bid * nw + wid; t < T_TOK; t += nblk * nw) {
        const float* xrow = H + (size_t)t * DM;
        f32x4 v[4]; float ss = 0.f;
#pragma unroll
        for (int j = 0; j < 4; ++j) { v[j] = *(const f32x4*)(xrow + j * 256 + lane * 4); ss += v[j][0] * v[j][0] + v[j][1] * v[j][1] + v[j][2] * v[j][2] + v[j][3] * v[j][3]; }
        ss = wave_sum(ss);
        const float rstd = rsqrtf(ss * (1.0f / 1024.0f) + RMS_EPS);
        float lg[NE];
#pragma unroll
        for (int e = 0; e < NE; ++e) lg[e] = 0.f;
#pragma unroll
        for (int j = 0; j < 4; ++j) {
            const f32x4 gg = *(const f32x4*)(g + j * 256 + lane * 4);
            float u[4];
#pragma unroll
            for (int i = 0; i < 4; ++i) u[i] = v[j][i] * rstd * gg[i];
            u32x2 w; w.x = pk2(u[0], u[1]); w.y = pk2(u[2], u[3]);
            *(u32x2*)(U + (size_t)t * DM + j * 256 + lane * 4) = w;
#pragma unroll
            for (int i = 0; i < 4; ++i) {
                const float* wrow = wr + (size_t)(j * 256 + lane * 4 + i) * NE;
#pragma unroll
                for (int e4 = 0; e4 < NE; e4 += 4) { const f32x4 ww = *(const f32x4*)(wrow + e4); lg[e4] += u[i] * ww[0]; lg[e4 + 1] += u[i] * ww[1]; lg[e4 + 2] += u[i] * ww[2]; lg[e4 + 3] += u[i] * ww[3]; }
            }
        }
#pragma unroll
        for (int e = 0; e < NE; ++e) lg[e] = wave_sum(lg[e]) + br[e];
        unsigned used = 0u; float bv[4]; int bi[4];
#pragma unroll
        for (int k = 0; k < TOPK; ++k) {
            float best = -INFINITY; int idx = 0;
#pragma unroll
            for (int e = 0; e < NE; ++e) { const bool ok = !((used >> e) & 1u) && (lg[e] > best); best = ok ? lg[e] : best; idx = ok ? e : idx; }
            used |= 1u << idx; bv[k] = best; bi[k] = idx;
        }
        float w[4], ws_ = 0.f;
#pragma unroll
        for (int k = 0; k < TOPK; ++k) { w[k] = __expf(bv[k] - bv[0]); ws_ += w[k]; }
        if (lane == 0) {
#pragma unroll
            for (int k = 0; k < TOPK; ++k) {
                const int e = bi[k];
                const int pos = atomicAdd(&cnt[e], 1);
                list[e * ECAP + pos] = t;
                tokslot[t * 4 + k] = (e << 16) | pos;
                gates[t * 4 + k] = w[k] / ws_;
            }
        }
    }
}
__device__ void phase_moe_g1(const Params& p, int layer, int* ps, int bid, int nblk) {
    const int* cnt = (const int*)(p.ws + WS_CTL) + CW_CNT + layer * NE; const int* list = (const int*)(p.ws + WS_LIST);
    moe_pstart(cnt, ps);
    const bf16_t* U = (const bf16_t*)(p.ws + WS_U); bf16_t* ACT = (bf16_t*)(p.ws + WS_ACT);
    const bf16_t* W = (const bf16_t*)(p.ws + WT_GU) + (size_t)layer * NE * 2048 * 1024; const float* bgu = p.in[I_MOE_BGU] + (size_t)layer * NE * 2048;
    const int wid = threadIdx.x >> 6, lane = threadIdx.x & 63, r32 = lane & 31, hi = lane >> 5, nw = blockDim.x >> 6;
    const int Mt = ps[NE] / 32, Nt = 32; const long total = (long)Mt * Nt;
    for (long tile = (long)bid * nw + wid; tile < total; tile += (long)nblk * nw) {
        const int tm = (int)(tile / Nt), tn = (int)(tile % Nt);
        const int prow0 = tm * 32; int e = 0;
#pragma unroll 1
        for (int q = 1; q < NE; ++q) if (ps[q] <= prow0) e = q;
        const int ce = cnt[e]; int idx = prow0 - ps[e] + r32; idx = idx < ce ? idx : ce - 1;
        const int tok = list[e * ECAP + idx];
        const bf16_t* ap = U + (size_t)tok * DM + hi * 8;
        const bf16_t* bg = W + ((size_t)e * 2048 + tn * 32 + r32) * 1024 + hi * 8;
        const bf16_t* bu = bg + (size_t)1024 * 1024;
        f32x16 ag = {}, au = {};
        for (int k = 0; k < 1024; k += 16) {
            const bf16x8 a = *(const bf16x8*)(ap + k);
            ag = __builtin_amdgcn_mfma_f32_32x32x16_bf16(a, *(const bf16x8*)(bg + k), ag, 0, 0, 0);
            au = __builtin_amdgcn_mfma_f32_32x32x16_bf16(a, *(const bf16x8*)(bu + k), au, 0, 0, 0);
        }
        const int col = tn * 32 + r32; const float bgv = bgu[e * 2048 + col], buv = bgu[e * 2048 + 1024 + col];
#pragma unroll
        for (int r = 0; r < 16; ++r) {
            float gt = ag[r] + bgv, up = au[r] + buv;
            gt = fminf(gt, 7.0f); up = fminf(fmaxf(up, -7.0f), 7.0f);
            const float glu = gt * sigmoidf_(1.702f * gt);
            ACT[(size_t)(prow0 + crow(r, hi)) * DM + col] = f2bf((up + 1.0f) * glu);
        }
    }
}
__device__ void phase_moe_g2(const Params& p, int layer, int* ps, int bid, int nblk) {
    const int* cnt = (const int*)(p.ws + WS_CTL) + CW_CNT + layer * NE;
    moe_pstart(cnt, ps);
    const bf16_t* ACT = (const bf16_t*)(p.ws + WS_ACT); bf16_t* YS = (bf16_t*)(p.ws + WS_YS);
    const bf16_t* W = (const bf16_t*)(p.ws + WT_DN) + (size_t)layer * NE * 1024 * 1024; const float* bdn = p.in[I_MOE_BDN] + (size_t)layer * NE * 1024;
    const int wid = threadIdx.x >> 6, lane = threadIdx.x & 63, r32 = lane & 31, hi = lane >> 5, nw = blockDim.x >> 6;
    const int Mt = ps[NE] / 32, Nt = 32; const long total = (long)Mt * Nt;
    for (long tile = (long)bid * nw + wid; tile < total; tile += (long)nblk * nw) {
        const int tm = (int)(tile / Nt), tn = (int)(tile % Nt);
        const int prow0 = tm * 32; int e = 0;
#pragma unroll 1
        for (int q = 1; q < NE; ++q) if (ps[q] <= prow0) e = q;
        const bf16_t* ap = ACT + (size_t)(prow0 + r32) * DM + hi * 8;
        const bf16_t* bp = W + ((size_t)e * 1024 + tn * 32 + r32) * 1024 + hi * 8;
        f32x16 acc = {};
        for (int k = 0; k < 1024; k += 16) acc = __builtin_amdgcn_mfma_f32_32x32x16_bf16(*(const bf16x8*)(ap + k), *(const bf16x8*)(bp + k), acc, 0, 0, 0);
        const int col = tn * 32 + r32; const float bv = bdn[e * 1024 + col];
#pragma unroll
        for (int r = 0; r < 16; ++r) YS[(size_t)(prow0 + crow(r, hi)) * DM + col] = f2bf(acc[r] + bv);
    }
}
__device__ void phase_moe_comb(const Params& p, int layer, int* ps, int bid, int nblk) {
    const int* cnt = (const int*)(p.ws + WS_CTL) + CW_CNT + layer * NE;
    moe_pstart(cnt, ps);
    float* H = (float*)(p.ws + WS_H); bf16_t* U = (bf16_t*)(p.ws + WS_U); const bf16_t* YS = (const bf16_t*)(p.ws + WS_YS);
    const int* tokslot = (const int*)(p.ws + WS_TOKSLOT); const float* gates = (const float*)(p.ws + WS_GATES);
    const bool last = (layer == 3);
    const float* g = last ? p.in[I_FINN] : p.in[I_MIXN] + (size_t)(layer + 1) * DM;
    const int wid = threadIdx.x >> 6, lane = threadIdx.x & 63, nw = blockDim.x >> 6;
    for (int t = bid * nw + wid; t < T_TOK; t += nblk * nw) {
        float* hrow = H + (size_t)t * DM;
        f32x4 v[4];
#pragma unroll
        for (int j = 0; j < 4; ++j) v[j] = *(const f32x4*)(hrow + j * 256 + lane * 4);
#pragma unroll
        for (int k = 0; k < TOPK; ++k) {
            const int sl = tokslot[t * 4 + k]; const float gw = gates[t * 4 + k];
            const size_t row = (size_t)(ps[sl >> 16] + (sl & 0xffff));
            const bf16_t* yr = YS + row * DM;
#pragma unroll
            for (int j = 0; j < 4; ++j) {
                const u32x2 w = *(const u32x2*)(yr + j * 256 + lane * 4);
                v[j][0] += gw * __uint_as_float(w.x << 16); v[j][1] += gw * __uint_as_float(w.x & 0xffff0000u);
                v[j][2] += gw * __uint_as_float(w.y << 16); v[j][3] += gw * __uint_as_float(w.y & 0xffff0000u);
            }
        }
        float ss = 0.f;
#pragma unroll
        for (int j = 0; j < 4; ++j) ss += v[j][0] * v[j][0] + v[j][1] * v[j][1] + v[j][2] * v[j][2] + v[j][3] * v[j][3];
        ss = wave_sum(ss);
        const float rstd = rsqrtf(ss * (1.0f / 1024.0f) + RMS_EPS);
#pragma unroll
        for (int j = 0; j < 4; ++j) {
            const f32x4 gg = *(const f32x4*)(g + j * 256 + lane * 4);
            if (last) {
                f32x4 o; o[0] = v[j][0] * rstd * gg[0]; o[1] = v[j][1] * rstd * gg[1]; o[2] = v[j][2] * rstd * gg[2]; o[3] = v[j][3] * rstd * gg[3];
                *(f32x4*)(p.out + (size_t)t * DM + j * 256 + lane * 4) = o;
            } else {
                *(f32x4*)(hrow + j * 256 + lane * 4) = v[j];
                u32x2 w; w.x = pk2(v[j][0] * rstd * gg[0], v[j][1] * rstd * gg[1]); w.y = pk2(v[j][2] * rstd * gg[2], v[j][3] * rstd * gg[3]);
                *(u32x2*)(U + (size_t)t * DM + j * 256 + lane * 4) = w;
            }
        }
    }
}

enum { PH_PREP = 0, PH_LRU_IN, PH_LRU_CONV, PH_LRU_BD, PH_LRU_SCAN, PH_LRU_OUT, PH_POOL_IN, PH_POOL_POOL, PH_POOL_GRP, PH_POOL_OUT,
       PH_SB_QKV, PH_SB_ATTN, PH_SB_OUT, PH_MOE_ROUTE, PH_MOE_G1, PH_MOE_G2, PH_MOE_COMB };

template <int PH>
__global__ void __launch_bounds__(512, 2) k_phase(Params p, int layer) {
    __shared__ __attribute__((aligned(16))) unsigned char lds[40960];
    int* ps = (int*)lds;
    const int bid = blockIdx.x, nblk = gridDim.x;
    unsigned char* ws = p.ws;
    const int slot = layer / 3;
    const float* hin = (layer == 0) ? p.in[I_X] : (const float*)(ws + WS_H);
    float* H = (float*)(ws + WS_H);
    const bf16_t* U = (const bf16_t*)(ws + WS_U);
    bf16_t* B0 = (bf16_t*)(ws + WS_B0); bf16_t* B1 = (bf16_t*)(ws + WS_B1); bf16_t* B2 = (bf16_t*)(ws + WS_B2); bf16_t* B3 = (bf16_t*)(ws + WS_B3);
    if constexpr (PH == PH_PREP) phase_prep(p, lds, bid, nblk);
    else if constexpr (PH == PH_LRU_IN) gemm_simple(U, DM, (const bf16_t*)(ws + WT_LRU_IN) + (size_t)slot * 2048 * 1024, DM, T_TOK / 32, 2048 / 32, DM, RowId{}, EpiLruIn{B0, B1}, bid, nblk);
    else if constexpr (PH == PH_LRU_CONV) phase_lru_conv(p, slot, bid, nblk);
    else if constexpr (PH == PH_LRU_BD) {
        for (int g = 0; g < 8; ++g) {
            gemm_simple(B2 + g * 128, DM, (const bf16_t*)(ws + WT_LRU_A) + (size_t)(slot * 8 + g) * 128 * 128, 128, T_TOK / 32, 4, 128, RowId{}, EpiF32{(float*)(ws + WS_ACT), DM, g * 128}, bid, nblk);
            gemm_simple(B2 + g * 128, DM, (const bf16_t*)(ws + WT_LRU_X) + (size_t)(slot * 8 + g) * 128 * 128, 128, T_TOK / 32, 4, 128, RowId{}, EpiF32{(float*)(ws + WS_YS), DM, g * 128}, bid, nblk);
        }
    }
    else if constexpr (PH == PH_LRU_SCAN) phase_lru_scan(p, slot, bid, nblk);
    else if constexpr (PH == PH_LRU_OUT) gemm_simple(B3, DM, (const bf16_t*)(ws + WT_LRU_OUT) + (size_t)slot * 1024 * 1024, DM, T_TOK / 32, 32, DM, RowId{}, EpiResid{hin, H}, bid, nblk);
    else if constexpr (PH == PH_POOL_IN) gemm_simple(U, DM, (const bf16_t*)(ws + WT_POOL_IN), DM, T_TOK / 32, 32, DM, RowId{}, EpiBf16{B0, DM, 0}, bid, nblk);
    else if constexpr (PH == PH_POOL_POOL) phase_pool_pool(p, bid, nblk);
    else if constexpr (PH == PH_POOL_GRP) {
        for (int g = 0; g < 4; ++g)
            gemm_simple(B1 + g * 256, DM, (const bf16_t*)(ws + WT_POOL_G) + (size_t)g * 256 * 256, 256, T_TOK / 32, 8, 256, RowId{}, EpiBf16Scale{B2, DM, g * 256, p.in[I_POOL_SC]}, bid, nblk);
    }
    else if constexpr (PH == PH_POOL_OUT) gemm_simple(B2, DM, (const bf16_t*)(ws + WT_POOL_OUT), DM, T_TOK / 32, 32, DM, RowId{}, EpiResid{hin, H}, bid, nblk);
    else if constexpr (PH == PH_SB_QKV) gemm_simple(U, DM, (const bf16_t*)(ws + WT_QKV), DM, T_TOK / 32, 96, DM, RowId{}, EpiQKV{B0, B1, B2, 0.125f * 1.4426950408889634f}, bid, nblk);
    else if constexpr (PH == PH_SB_ATTN) phase_sb_attn(p, bid, nblk);
    else if constexpr (PH == PH_SB_OUT) gemm_simple(B3, DM, (const bf16_t*)(ws + WT_SB_OUT), DM, T_TOK / 32, 32, DM, RowId{}, EpiResid{hin, H}, bid, nblk);
    else if constexpr (PH == PH_MOE_ROUTE) phase_moe_route(p, layer, bid, nblk);
    else if constexpr (PH == PH_MOE_G1) phase_moe_g1(p, layer, ps, bid, nblk);
    else if constexpr (PH == PH_MOE_G2) phase_moe_g2(p, layer, ps, bid, nblk);
    else if constexpr (PH == PH_MOE_COMB) phase_moe_comb(p, layer, ps, bid, nblk);
}

extern "C" void kernel_launch(void* const* d_in, const int* in_sizes, int n_in, void* d_out, int out_size, void* d_ws, size_t ws_size, hipStream_t stream) {
    Params p{};
    for (int i = 0; i < 25; ++i) p.in[i] = (const float*)d_in[i];
    p.out = (float*)d_out; p.ws = (unsigned char*)d_ws;
    hipMemsetAsync(d_ws, 0, 1 * MB, stream);
    const dim3 grid(1024), blk(512);
#define LAUNCH(PH, L) hipLaunchKernelGGL(k_phase<PH>, grid, blk, 0, stream, p, (int)(L))
    LAUNCH(PH_PREP, 0);
    for (int layer = 0; layer < 4; ++layer) {
        const int kind = layer % 3;
        if (kind == 0) { LAUNCH(PH_LRU_IN, layer); LAUNCH(PH_LRU_CONV, layer); LAUNCH(PH_LRU_BD, layer); LAUNCH(PH_LRU_SCAN, layer); LAUNCH(PH_LRU_OUT, layer); }
        else if (kind == 1) { LAUNCH(PH_POOL_IN, layer); LAUNCH(PH_POOL_POOL, layer); LAUNCH(PH_POOL_GRP, layer); LAUNCH(PH_POOL_OUT, layer); }
        else { LAUNCH(PH_SB_QKV, layer); LAUNCH(PH_SB_ATTN, layer); LAUNCH(PH_SB_OUT, layer); }
        LAUNCH(PH_MOE_ROUTE, layer); LAUNCH(PH_MOE_G1, layer); LAUNCH(PH_MOE_G2, layer); LAUNCH(PH_MOE_COMB, layer);
    }
#undef LAUNCH
}
```

```cpp
#include <hip/hip_runtime.h>
#include <stdint.h>

typedef unsigned short bf16_t;
typedef short bf16x8 __attribute__((ext_vector_type(8)));
typedef float f32x16 __attribute__((ext_vector_type(16)));
typedef float f32x4 __attribute__((ext_vector_type(4)));
typedef float f32x2_t __attribute__((ext_vector_type(2)));
typedef __bf16 bf16x2_t __attribute__((ext_vector_type(2)));
typedef unsigned u32x4 __attribute__((ext_vector_type(4)));
typedef unsigned u32x2 __attribute__((ext_vector_type(2)));

constexpr int T_TOK = 16384, DM = 1024, SEQ = 2048, NB = 8, NE = 32, TOPK = 4, NH = 16, HD = 64;
constexpr float SWI_C = 2.4554669595930157f;
constexpr int ECAP = 16384;
constexpr int PADROWS = 65536 + 32 * 256;
constexpr float RMS_EPS = 1e-6f;

constexpr size_t MB = 1024ull * 1024ull;
constexpr size_t WS_CTL = 0;
constexpr size_t WS_LIST = 1 * MB;
constexpr size_t WS_TOKSLOT = 3 * MB;
constexpr size_t WS_GATES = 4 * MB;
constexpr size_t WS_H = 8 * MB;
constexpr size_t WS_U = WS_H + 64 * MB;
constexpr size_t WS_B0 = WS_U + 32 * MB;
constexpr size_t WS_U8 = WS_U + 16 * MB;
constexpr size_t WS_B1 = WS_B0 + 32 * MB;
constexpr size_t WS_B2 = WS_B1 + 32 * MB;
constexpr size_t WS_B3 = WS_B2 + 32 * MB;
constexpr size_t WS_ACT = WS_B3 + 32 * MB;
constexpr size_t WS_YS = WS_ACT + 160 * MB;
constexpr size_t WS_W = WS_YS + 160 * MB;
constexpr size_t WT_LRU_IN = WS_W;
constexpr size_t WT_LRU_OUT = WT_LRU_IN + 8 * MB;
constexpr size_t WT_POOL_IN = WT_LRU_OUT + 4 * MB;
constexpr size_t WT_POOL_G = WT_POOL_IN + 2 * MB;
constexpr size_t WT_POOL_OUT = WT_POOL_G + 1 * MB;
constexpr size_t WT_QKV = WT_POOL_OUT + 2 * MB;
constexpr size_t WT_SB_OUT = WT_QKV + 6 * MB;
constexpr size_t WT_LRU_A = WT_SB_OUT + 2 * MB;
constexpr size_t WT_LRU_X = WT_LRU_A + 1 * MB;
constexpr size_t WT_ROUTER = WT_LRU_X + 1 * MB;
constexpr size_t WT_GU = WT_ROUTER + 1 * MB;
constexpr size_t WT_DN = WT_GU + 512 * MB;
constexpr size_t WS_END = WT_DN + 256 * MB;
constexpr int CW_CNT = 8192;

struct Params {
    const float* in[25];
    float* out;
    unsigned char* ws;
};
enum { I_X = 0, I_MIXN, I_FFNN, I_FINN, I_LRU_WIN, I_LRU_CW, I_LRU_CB, I_LRU_WA, I_LRU_BA, I_LRU_WX, I_LRU_BX, I_LRU_AP, I_LRU_WOUT,
       I_POOL_WIN, I_POOL_WG, I_POOL_SC, I_POOL_WOUT, I_SB_WQKV, I_SB_WOUT, I_MOE_WR, I_MOE_BR, I_MOE_WGU, I_MOE_BGU, I_MOE_WDN, I_MOE_BDN };

constexpr unsigned LDS_WTAB = 147456u - 64u;
__device__ __forceinline__ unsigned hw_slot_id() { return (unsigned)__builtin_amdgcn_s_getreg(((16 - 1) << 11) | 4); }
__device__ __forceinline__ int tid_opaque() {
    const unsigned hw = hw_slot_id();
    unsigned m = ~0u; asm volatile("" : "+s"(m));
    const int lane = (int)__builtin_amdgcn_mbcnt_hi(m, __builtin_amdgcn_mbcnt_lo(m, 0u));
    const unsigned ent = *(const volatile __attribute__((address_space(3))) unsigned*)(LDS_WTAB + (unsigned)(lane & 7) * 4u);
    const int wi = __builtin_ctzll(__builtin_amdgcn_ballot_w64(ent == hw));
    int t = wi * 64 + lane; asm volatile("" : "+v"(t)); return t;
}
__device__ __forceinline__ float bf2f(bf16_t b) { return __uint_as_float(((unsigned)b) << 16); }
__device__ __forceinline__ unsigned pk2(float lo, float hi) { f32x2_t v = {lo, hi}; bf16x2_t b = __builtin_convertvector(v, bf16x2_t); return __builtin_bit_cast(unsigned, b); }
__device__ __forceinline__ bf16_t f2bf(float f) { return (bf16_t)(pk2(f, 0.f) & 0xffffu); }
__device__ __forceinline__ int crow(int r, int hi) { return (r & 3) + 8 * (r >> 2) + 4 * hi; }
__device__ __forceinline__ float shx(float v, int o, int lane) { return __int_as_float(__builtin_amdgcn_ds_bpermute((lane ^ o) << 2, __float_as_int(v))); }
__device__ __forceinline__ float wave_sum(float v, int lane) {
#pragma unroll
    for (int o = 32; o >= 1; o >>= 1) v += shx(v, o, lane);
    return v;
}
__device__ __forceinline__ void convT_small(const float* src, bf16_t* dst, int nbat, int K, int N, int bid, int nblk) {
    const int tidx = tid_opaque();
    const size_t total = (size_t)nbat * K * N;
    for (size_t i = (size_t)bid * blockDim.x + tidx; i < total; i += (size_t)nblk * blockDim.x) {
        const size_t m = i / ((size_t)K * N), r = i % ((size_t)K * N);
        const int n = (int)(r / K), k = (int)(r % K);
        dst[i] = f2bf(src[m * K * N + (size_t)k * N + n]);
    }
}

__device__ __forceinline__ void norm_row_wave(const float* __restrict__ xrow, const float* __restrict__ g, bf16_t* __restrict__ orow, int lane) {
    f32x4 v[4]; float ss = 0.f;
#pragma unroll
    for (int j = 0; j < 4; ++j) { v[j] = *(const f32x4*)(xrow + j * 256 + lane * 4); ss += v[j][0] * v[j][0] + v[j][1] * v[j][1] + v[j][2] * v[j][2] + v[j][3] * v[j][3]; }
    ss = wave_sum(ss, lane);
    const float rstd = rsqrtf(ss * (1.0f / 1024.0f) + RMS_EPS);
#pragma unroll
    for (int j = 0; j < 4; ++j) {
        const f32x4 gg = *(const f32x4*)(g + j * 256 + lane * 4);
        u32x2 w; w.x = pk2(v[j][0] * rstd * gg[0], v[j][1] * rstd * gg[1]); w.y = pk2(v[j][2] * rstd * gg[2], v[j][3] * rstd * gg[3]);
        *(u32x2*)(orow + j * 256 + lane * 4) = w;
    }
}

__device__ __forceinline__ float clamp448_early(float x) { return __builtin_fminf(__builtin_fmaxf(x, -448.0f), 448.0f); }
__device__ __forceinline__ u32x2 pack8_fp8_early(const f32x4& a, const f32x4& b) {
    int w0 = 0, w1 = 0;
    w0 = __builtin_amdgcn_cvt_pk_fp8_f32(clamp448_early(a[0]), clamp448_early(a[1]), w0, false); w0 = __builtin_amdgcn_cvt_pk_fp8_f32(clamp448_early(a[2]), clamp448_early(a[3]), w0, true);
    w1 = __builtin_amdgcn_cvt_pk_fp8_f32(clamp448_early(b[0]), clamp448_early(b[1]), w1, false); w1 = __builtin_amdgcn_cvt_pk_fp8_f32(clamp448_early(b[2]), clamp448_early(b[3]), w1, true);
    u32x2 r; r.x = (unsigned)w0; r.y = (unsigned)w1; return r;
}
struct PrepJob { const float* src; bf16_t* dst; int K, N; int k0, n0; int f8; };
__device__ __forceinline__ bool prep_decode(const Params& p, int u, PrepJob& J) {
    unsigned char* ws = p.ws;
    const int idx[7] = {I_LRU_WIN, I_LRU_WOUT, I_POOL_WIN, I_POOL_WG, I_POOL_WOUT, I_SB_WQKV, I_SB_WOUT};
    const size_t off[7] = {WT_LRU_IN, WT_LRU_OUT, WT_POOL_IN, WT_POOL_G, WT_POOL_OUT, WT_QKV, WT_SB_OUT};
    const int nbat[7] = {2, 2, 1, 4, 1, 1, 1};
    const int Ks[7] = {1024, 1024, 1024, 256, 1024, 1024, 1024};
    const int Ns[7] = {2048, 1024, 1024, 256, 1024, 3072, 1024};
    const int F8[7] = {1, 0, 1, 0, 0, 1, 0};
    int rem = u;
#pragma unroll
    for (int j = 0; j < 7; ++j) {
        const int ntl = Ns[j] / 256, per = (Ks[j] / 64) * ntl, tot = nbat[j] * per;
        if (rem < tot) {
            const int m = rem / per, r = rem % per;
            J.src = p.in[idx[j]] + (size_t)m * Ks[j] * Ns[j]; J.f8 = F8[j];
            J.dst = F8[j] ? (bf16_t*)(ws + off[j] + (size_t)m * Ks[j] * Ns[j]) : (bf16_t*)(ws + off[j]) + (size_t)m * Ks[j] * Ns[j];
            J.K = Ks[j]; J.N = Ns[j]; J.k0 = (r / ntl) * 64; J.n0 = (r % ntl) * 256; return true;
        }
        rem -= tot;
    }
    return false;
}
__device__ __forceinline__ void phase_prep(const Params& p, unsigned char* lds, int bid, int nblk) {
    const int tidx = tid_opaque();
    unsigned char* ws = p.ws;
    const int lane = tidx & 63, kg = tidx >> 6;
    {
        PrepJob J, Jn; f32x4 v[8], vn[8];
        bool have = prep_decode(p, bid, J);
        if (have) {
#pragma unroll
            for (int j = 0; j < 8; ++j) v[j] = *(const f32x4*)(J.src + (size_t)(J.k0 + kg * 8 + j) * J.N + J.n0 + lane * 4);
        }
#pragma unroll 1
        for (int u = bid; have; u += nblk) {
            const bool hn = prep_decode(p, u + nblk, Jn);
            if (hn) {
#pragma unroll
                for (int j = 0; j < 8; ++j) vn[j] = *(const f32x4*)(Jn.src + (size_t)(Jn.k0 + kg * 8 + j) * Jn.N + Jn.n0 + lane * 4);
            }
            if (J.f8) {
#pragma unroll
                for (int i = 0; i < 4; ++i) {
                    f32x4 a, b; a[0] = v[0][i] * 32.0f; a[1] = v[1][i] * 32.0f; a[2] = v[2][i] * 32.0f; a[3] = v[3][i] * 32.0f; b[0] = v[4][i] * 32.0f; b[1] = v[5][i] * 32.0f; b[2] = v[6][i] * 32.0f; b[3] = v[7][i] * 32.0f;
                    *(u32x2*)(lds + (lane * 4 + i) * 72 + kg * 8) = pack8_fp8_early(a, b);
                }
                __syncthreads();
#pragma unroll
                for (int q = 0; q < 2; ++q) {
                    const int n = q * 128 + (tidx >> 2), ch = tidx & 3;
                    u32x4 w; const u32x2 w0 = *(const u32x2*)(lds + n * 72 + ch * 16), w1 = *(const u32x2*)(lds + n * 72 + ch * 16 + 8); w.x = w0.x; w.y = w0.y; w.z = w1.x; w.w = w1.y;
                    *(u32x4*)((unsigned char*)J.dst + (size_t)(J.n0 + n) * J.K + J.k0 + ch * 16) = w;
                }
            } else {
#pragma unroll
            for (int i = 0; i < 4; ++i) {
                u32x4 w;
                w.x = pk2(v[0][i], v[1][i]); w.y = pk2(v[2][i], v[3][i]); w.z = pk2(v[4][i], v[5][i]); w.w = pk2(v[6][i], v[7][i]);
                *(u32x4*)(lds + (lane * 4 + i) * 144 + kg * 16) = w;
            }
            __syncthreads();
#pragma unroll
            for (int q = 0; q < 4; ++q) {
                const int n = q * 64 + (tidx >> 3), ch = tidx & 7;
                const u32x4 w = *(const u32x4*)(lds + n * 144 + ch * 16);
                *(u32x4*)(J.dst + (size_t)(J.n0 + n) * J.K + J.k0 + ch * 8) = w;
            }
            }
            __syncthreads();
            have = hn; J = Jn;
#pragma unroll
            for (int j = 0; j < 8; ++j) v[j] = vn[j];
        }
    }
    convT_small(p.in[I_LRU_WA], (bf16_t*)(ws + WT_LRU_A), 16, 128, 128, bid, nblk);
    convT_small(p.in[I_LRU_WX], (bf16_t*)(ws + WT_LRU_X), 16, 128, 128, bid, nblk);
    convT_small(p.in[I_MOE_WR], (bf16_t*)(ws + WT_ROUTER), 4, 1024, 32, bid, nblk);
    const int wid = tidx >> 6, nw = blockDim.x >> 6;
    f32x4 gg[4];
#pragma unroll
    for (int j = 0; j < 4; ++j) gg[j] = *(const f32x4*)(p.in[I_MIXN] + j * 256 + lane * 4);
#pragma unroll 1
    for (int t0 = (bid * nw + wid) * 4; t0 < T_TOK; t0 += nblk * nw * 4) {
        f32x4 v[4][4];
#pragma unroll
        for (int a = 0; a < 4; ++a)
#pragma unroll
            for (int j = 0; j < 4; ++j) v[a][j] = *(const f32x4*)(p.in[I_X] + (size_t)(t0 + a) * DM + j * 256 + lane * 4);
#pragma unroll
        for (int a = 0; a < 4; ++a) {
            float ss = 0.f;
#pragma unroll
            for (int j = 0; j < 4; ++j) ss += v[a][j][0] * v[a][j][0] + v[a][j][1] * v[a][j][1] + v[a][j][2] * v[a][j][2] + v[a][j][3] * v[a][j][3];
            ss = wave_sum(ss, lane);
            const float rstd = rsqrtf(ss * (1.0f / 1024.0f) + RMS_EPS);
            unsigned char* orow = ws + WS_U + (size_t)(t0 + a) * DM;
#pragma unroll
            for (int j = 0; j < 4; ++j) {
                int w8 = 0;
                w8 = __builtin_amdgcn_cvt_pk_fp8_f32(clamp448_early(v[a][j][0] * rstd * gg[j][0]), clamp448_early(v[a][j][1] * rstd * gg[j][1]), w8, false);
                w8 = __builtin_amdgcn_cvt_pk_fp8_f32(clamp448_early(v[a][j][2] * rstd * gg[j][2]), clamp448_early(v[a][j][3] * rstd * gg[j][3]), w8, true);
                *(int*)(orow + j * 256 + lane * 4) = w8;
            }
        }
    }
}

#define LAS __attribute__((address_space(3)))
namespace g8 {
constexpr int HTB = 128 * 64 * 2;
constexpr int STAGE_BYTES = 8 * HTB;
__device__ __forceinline__ int lds_byte(int r, int c) { const int st = (r >> 4) * 2 + (c >> 5), rr = r & 15, cc = c & 31, ob = rr * 64 + cc * 2; return st * 1024 + (ob ^ (((ob >> 9) & 1) << 5)); }
__device__ __forceinline__ void stage_rc(int b, int& R, int& C) { const int st = b / 1024, sb = b % 1024, swz = sb ^ (((sb >> 9) & 1) << 5); R = (st >> 1) * 16 + swz / 64; C = (st & 1) * 32 + (swz % 64) / 2; }
__device__ __forceinline__ int perm32(int rho) { const int n = rho >> 4, i = rho & 15; return 8 * (i >> 2) + 4 * n + (i & 3); }

struct Unit { const char* Bb; int a0; int orow; int ocol; int e; };

typedef f32x4 Acc[2][2][4][2];

typedef int v8i __attribute__((ext_vector_type(8)));
typedef int v4i __attribute__((ext_vector_type(4)));
template <class Sched, class Epi, int FP8 = 0>
__device__ __forceinline__ void gemm_phase(LAS unsigned char* lds, const char* Abase, int ldb_bytes, int nt, const Sched& S, const Epi& E, int wscale = 0x7F7F7F7F) {
    const int tid = tid_opaque(), wid = __builtin_amdgcn_readfirstlane(tid >> 6), lane = tid & 63, wr = wid >> 2, wc = wid & 3, fr = lane & 15, fq = lane >> 4;
    int R[2], C[2]; unsigned voffB[2];
#pragma unroll
    for (int i = 0; i < 2; ++i) { stage_rc(tid * 16 + i * 8192, R[i], C[i]); const int Rb = (R[i] & ~31) + perm32(R[i] & 31); voffB[i] = (unsigned)(Rb * ldb_bytes + C[i] * 2); }
    const unsigned ldsw = (unsigned)wid * 1024u;
    const int aoffl = lds_byte(wr * 64 + fr, fq * 8), boffl = lds_byte(wc * 32 + fr, fq * 8);
#define G8_SA(b, h) (((b) * 2 + (h)) * g8::HTB)
#define G8_SB(b, h) ((4 + (b) * 2 + (h)) * g8::HTB)
#define G8_STG_A(bufoff, kptr, h) do { _Pragma("unroll") for (int _i = 0; _i < 2; ++_i) \
        __builtin_amdgcn_global_load_lds((const unsigned*)((const char*)(kptr) + aoff[h][_i]), (LAS unsigned*)(lds + (bufoff) + ldsw + _i * 8192), 16, 0, 0); } while (0)
#define G8_STG_B(bufoff, bptr) do { _Pragma("unroll") for (int _i = 0; _i < 2; ++_i) \
        __builtin_amdgcn_global_load_lds((const unsigned*)((const char*)(bptr) + voffB[_i]), (LAS unsigned*)(lds + (bufoff) + ldsw + _i * 8192), 16, 0, 0); } while (0)
#define G8_LDA(dst, b, h) do { _Pragma("unroll") for (int m = 0; m < 4; ++m) _Pragma("unroll") for (int k = 0; k < 2; ++k) dst[m][k] = *(const LAS bf16x8*)(lds + G8_SA(b, h) + aoffl + m * 2048 + k * 1024); } while (0)
#define G8_LDB(dst, b, h) do { _Pragma("unroll") for (int n = 0; n < 2; ++n) _Pragma("unroll") for (int k = 0; k < 2; ++k) dst[n][k] = *(const LAS bf16x8*)(lds + G8_SB(b, h) + boffl + n * 2048 + k * 1024); } while (0)
#define G8_CAT(x) __builtin_shufflevector(__builtin_bit_cast(g8::v4i, x[0]), __builtin_bit_cast(g8::v4i, x[1]), 0, 1, 2, 3, 4, 5, 6, 7)
#define G8_MMA(ai, bj, At, Bt) do { __builtin_amdgcn_s_setprio(1); _Pragma("unroll") for (int m = 0; m < 4; ++m) _Pragma("unroll") for (int n = 0; n < 2; ++n) { \
        if (FP8) acc[ai][bj][m][n] = __builtin_amdgcn_mfma_scale_f32_16x16x128_f8f6f4(G8_CAT(Bt[n]), G8_CAT(At[m]), acc[ai][bj][m][n], 0, 0, 0, wscale, 0, 0x7F7F7F7F); \
        else { _Pragma("unroll") for (int k = 0; k < 2; ++k) acc[ai][bj][m][n] = __builtin_amdgcn_mfma_f32_16x16x32_bf16(Bt[n][k], At[m][k], acc[ai][bj][m][n], 0, 0, 0); } } \
        __builtin_amdgcn_s_setprio(0); } while (0)
#define G8_WAIT_V(n) asm volatile("s_waitcnt vmcnt(" #n ")" ::: "memory")
#define G8_WAIT_L(n) asm volatile("s_waitcnt lgkmcnt(" #n ")" ::: "memory")
#define G8_BAR __builtin_amdgcn_s_barrier()
#define G8_SCHED __builtin_amdgcn_sched_barrier(0)
    Unit cur, nxt; int ui = 0;
    if (!S.next(0, cur)) return;
    Acc acc;
    f32x4 ib[4];
    if constexpr (Epi::HAS_INIT) E.load_init(cur, wc, fq, ib);
#pragma unroll
    for (int a = 0; a < 2; ++a)
#pragma unroll
        for (int b = 0; b < 2; ++b)
#pragma unroll
            for (int m = 0; m < 4; ++m)
#pragma unroll
                for (int n = 0; n < 2; ++n) { if constexpr (Epi::HAS_INIT) acc[a][b][m][n] = ib[2 * b + n]; else acc[a][b][m][n] = (f32x4){0.f, 0.f, 0.f, 0.f}; }
    if constexpr (Epi::HAS_TILE_INIT) E.init_tile(acc, cur, wr, wc, fr, fq);
    bf16x8 At[4][2], B0[2][2], B1[2][2];
    unsigned aoff[2][2];
    S.aoffs(cur, R, C, aoff);
    const char* cB = cur.Bb; const int chB = S.hB();
#define G8_KOFF(u, s) ((size_t)(((s) & (nt - 1)) * 128))
    { const size_t k0 = G8_KOFF(cur, 0), k1 = G8_KOFF(cur, 1);
    G8_STG_B(G8_SB(0, 0), cB + k0); G8_STG_B(G8_SB(0, 1), cB + chB + k0); G8_STG_A(G8_SA(0, 0), Abase + k0, 0); G8_STG_A(G8_SA(0, 1), Abase + k0, 1);
    if (wr == 1) G8_BAR;
    G8_WAIT_V(2); G8_BAR;
    G8_STG_B(G8_SB(1, 0), cB + k1); G8_STG_A(G8_SA(1, 0), Abase + k1, 0); G8_STG_B(G8_SB(1, 1), cB + chB + k1);
    G8_WAIT_V(6); G8_BAR; }
    for (;;) {
        const bool has_next = S.next(ui + 1, nxt);
        const char* nB = has_next ? nxt.Bb : cB;
#pragma unroll 1
        for (int t = 0; t < nt; t += 2) {
            const bool last = (t == nt - 2);
            const Unit& nu = has_next ? nxt : cur;
            const size_t o1 = G8_KOFF(cur, t + 1), o2 = last ? G8_KOFF(nu, 0) : G8_KOFF(cur, t + 2), o3 = last ? G8_KOFF(nu, 1) : G8_KOFF(cur, t + 3);
            const char* a1 = Abase + o1;
            const char* a2 = Abase + o2; const char* b2 = (last ? nB : cB) + o2; const int hb2 = chB;
            const char* a3 = Abase + o3; const char* b3 = (last ? nB : cB) + o3;
            G8_LDB(B0, 0, 0); G8_LDB(B1, 0, 1); G8_SCHED; G8_LDA(At, 0, 0); G8_STG_A(G8_SA(1, 1), a1, 1);
            if (last && has_next) S.aoffs(nxt, R, C, aoff);
            G8_WAIT_V(8); G8_WAIT_L(0); G8_BAR; G8_MMA(0, 0, At, B0); G8_MMA(0, 1, At, B1); G8_BAR; G8_SCHED;
            G8_LDA(At, 0, 1); G8_STG_B(G8_SB(0, 0), b2); G8_STG_B(G8_SB(0, 1), b2 + hb2); G8_STG_A(G8_SA(0, 0), a2, 0);
            G8_WAIT_V(8); G8_WAIT_L(0); G8_BAR; G8_MMA(1, 0, At, B0); G8_MMA(1, 1, At, B1); G8_BAR; G8_SCHED;
            G8_LDB(B0, 1, 0); G8_LDB(B1, 1, 1); G8_SCHED; G8_LDA(At, 1, 0); G8_STG_A(G8_SA(0, 1), a2, 1);
            G8_WAIT_V(8); G8_WAIT_L(0); G8_BAR; G8_MMA(0, 0, At, B0); G8_MMA(0, 1, At, B1); G8_BAR; G8_SCHED;
            G8_LDA(At, 1, 1); G8_STG_B(G8_SB(1, 0), b3); G8_STG_B(G8_SB(1, 1), b3 + hb2); G8_STG_A(G8_SA(1, 0), a3, 0);
            G8_WAIT_V(8); G8_WAIT_L(0); G8_BAR; G8_MMA(1, 0, At, B0); G8_MMA(1, 1, At, B1); G8_BAR; G8_SCHED;
        }
        if (wr == 0) G8_BAR;
        if constexpr (Epi::HAS_INIT) { if (has_next) E.load_init(nxt, wc, fq, ib); }
        E(acc, cur, wr, wc, fr, fq);
        if (!has_next) break;
#pragma unroll
        for (int a = 0; a < 2; ++a)
#pragma unroll
            for (int b = 0; b < 2; ++b)
#pragma unroll
                for (int m = 0; m < 4; ++m)
#pragma unroll
                    for (int n = 0; n < 2; ++n) { if constexpr (Epi::HAS_INIT) acc[a][b][m][n] = ib[2 * b + n]; else acc[a][b][m][n] = (f32x4){0.f, 0.f, 0.f, 0.f}; }
        if constexpr (Epi::HAS_TILE_INIT) E.init_tile(acc, nxt, wr, wc, fr, fq);
        cur = nxt; cB = nB; ++ui;
        if (wr == 1) G8_BAR;
    }
    G8_WAIT_V(0);
    G8_BAR;
#undef G8_SA
#undef G8_SB
#undef G8_STG_A
#undef G8_STG_B
#undef G8_LDA
#undef G8_LDB
#undef G8_MMA
#undef G8_KOFF
#undef G8_CAT
#undef G8_WAIT_V
#undef G8_WAIT_L
#undef G8_BAR
#undef G8_SCHED
}

struct DenseSched {
    int nM, nN, nwg, G, c, abytes; const char* Bt; int bbytes; int acolB;
    __device__ __forceinline__ int hB() const { return 128 * bbytes; }
    __device__ __forceinline__ void init(int M, int N, int G_, int c_, int abytes_, const void* Bt_, int bbytes_, int acolB_) { nM = M / 256; nN = N / 256; nwg = nM * nN; G = G_; c = c_; abytes = abytes_; Bt = (const char*)Bt_; bbytes = bbytes_; acolB = acolB_; }
    __device__ __forceinline__ bool next(int i, Unit& u) const {
        const long L = (long)i * G + c; if (L >= nwg) return false;
        int wgid = (int)L; { const int q = nwg / 8, r = nwg % 8, xcd = wgid % 8, off = wgid / 8; wgid = (xcd < r ? xcd * (q + 1) : r * (q + 1) + (xcd - r) * q) + off; }
        const int nig = 8 * nN, gid = wgid / nig, fm = gid * 8, gsz = (nM - fm) < 8 ? (nM - fm) : 8;
        const int pm = fm + ((wgid % nig) % gsz), pn = (wgid % nig) / gsz;
        u.a0 = pm * 256; u.orow = pm * 256; u.ocol = pn * 256; u.e = 0; u.Bb = Bt + (size_t)pn * 256 * bbytes; return true;
    }
    __device__ __forceinline__ void aoffs(const Unit& u, const int (&R)[2], const int (&C)[2], unsigned (&aoff)[2][2]) const {
#pragma unroll
        for (int h = 0; h < 2; ++h)
#pragma unroll
            for (int i = 0; i < 2; ++i) aoff[h][i] = (unsigned)((u.a0 + h * 128 + R[i]) * abytes + acolB + C[i] * 2);
    }
};

__device__ __forceinline__ u32x4 pack8(const f32x4& a, const f32x4& b) { u32x4 w; w.x = pk2(a[0], a[1]); w.y = pk2(a[2], a[3]); w.z = pk2(b[0], b[1]); w.w = pk2(b[2], b[3]); return w; }
__device__ __forceinline__ float fast_rcp(float x) { return __builtin_amdgcn_rcpf(x); }
__device__ __forceinline__ float clamp448(float x) { return __builtin_fminf(__builtin_fmaxf(x, -448.0f), 448.0f); }
__device__ __forceinline__ u32x2 pack8_fp8(const f32x4& a, const f32x4& b) {
    int w0 = 0, w1 = 0;
    w0 = __builtin_amdgcn_cvt_pk_fp8_f32(clamp448(a[0]), clamp448(a[1]), w0, false); w0 = __builtin_amdgcn_cvt_pk_fp8_f32(clamp448(a[2]), clamp448(a[3]), w0, true);
    w1 = __builtin_amdgcn_cvt_pk_fp8_f32(clamp448(b[0]), clamp448(b[1]), w1, false); w1 = __builtin_amdgcn_cvt_pk_fp8_f32(clamp448(b[2]), clamp448(b[3]), w1, true);
    u32x2 r; r.x = (unsigned)w0; r.y = (unsigned)w1; return r;
}
__device__ __forceinline__ float clamp448m(float x) { return __builtin_amdgcn_fmed3f(x, -448.0f, 448.0f); }
__device__ __forceinline__ u32x2 pack8_fp8_m3(const f32x4& a, const f32x4& b) {
    int w0 = 0, w1 = 0;
    w0 = __builtin_amdgcn_cvt_pk_fp8_f32(clamp448m(a[0]), clamp448m(a[1]), w0, false); w0 = __builtin_amdgcn_cvt_pk_fp8_f32(clamp448m(a[2]), clamp448m(a[3]), w0, true);
    w1 = __builtin_amdgcn_cvt_pk_fp8_f32(clamp448m(b[0]), clamp448m(b[1]), w1, false); w1 = __builtin_amdgcn_cvt_pk_fp8_f32(clamp448m(b[2]), clamp448m(b[3]), w1, true);
    u32x2 r; r.x = (unsigned)w0; r.y = (unsigned)w1; return r;
}
__device__ __forceinline__ u32x2 pack8_fp8_noclamp(const f32x4& a, const f32x4& b) {
    int w0 = 0, w1 = 0;
    w0 = __builtin_amdgcn_cvt_pk_fp8_f32(a[0], a[1], w0, false); w0 = __builtin_amdgcn_cvt_pk_fp8_f32(a[2], a[3], w0, true);
    w1 = __builtin_amdgcn_cvt_pk_fp8_f32(b[0], b[1], w1, false); w1 = __builtin_amdgcn_cvt_pk_fp8_f32(b[2], b[3], w1, true);
    u32x2 r; r.x = (unsigned)w0; r.y = (unsigned)w1; return r;
}
__device__ __forceinline__ float gelu_fast(float x) { const float t = x * __builtin_fmaf(x * x, -0.10294324f, -2.3022082f); return x * fast_rcp(1.0f + __builtin_amdgcn_exp2f(t)); }
#define G8_FOR_ROWS for (int ai = 0; ai < 2; ++ai) for (int m = 0; m < 4; ++m)
__device__ __forceinline__ u32x4 rowmajor16(const u32x4& w, int srcb) {
    u32x4 r; r.x = (unsigned)__builtin_amdgcn_ds_bpermute(srcb, (int)w.x); r.y = (unsigned)__builtin_amdgcn_ds_bpermute(srcb, (int)w.y);
    r.z = (unsigned)__builtin_amdgcn_ds_bpermute(srcb, (int)w.z); r.w = (unsigned)__builtin_amdgcn_ds_bpermute(srcb, (int)w.w); return r;
}

template <int MODE> struct EpiB {
    bf16_t* o0; bf16_t* o1; bf16_t* o2; const float* sc; float qs; int ld; int coff;
    static constexpr bool HAS_INIT = (MODE == 4), HAS_TILE_INIT = false;
    __device__ __forceinline__ void load_init(const Unit& u, int wc, int fq, f32x4 (&b)[4]) const {
        const float* bp = sc + u.e * 1024 + u.ocol + coff + wc * 32 + 8 * fq;
#pragma unroll
        for (int bj = 0; bj < 2; ++bj) { b[2 * bj] = *(const f32x4*)(bp + bj * 128) * 16.0f; b[2 * bj + 1] = *(const f32x4*)(bp + bj * 128 + 4) * 16.0f; }
    }
    __device__ __forceinline__ void operator()(const Acc& acc, const Unit& u, int wr, int wc, int fr, int fq) const {
        if constexpr (MODE == 4) {
            int ln = fr + 16 * fq; asm volatile("" : "+v"(ln));
            unsigned char* yb = (unsigned char*)o0; const int c8 = u.ocol + coff + wc * 32 + 8 * (ln >> 4);
#pragma unroll
            G8_FOR_ROWS {
                unsigned char* rp = yb + (size_t)(u.orow + ai * 128 + wr * 64 + m * 16 + (ln & 15)) * ld + c8;
#pragma unroll
                for (int bj = 0; bj < 2; ++bj) *(u32x2*)(rp + bj * 128) = pack8_fp8_m3(acc[ai][bj][m][0], acc[ai][bj][m][1]);
            }
            return;
        }
        bf16_t* base = o0; int col = u.ocol; float mul = 1.0f; bool gel = false;
        if (MODE == 1) { if (col < 1024) gel = true; else { base = o1; col -= 1024; } }
        if (MODE == 2) { if (col < 1024) mul = qs; else if (col < 2048) { base = o1; col -= 1024; } else { base = o2; col -= 2048; } }
        const int ln = fr + 16 * fq, fr2 = ln >> 2, fq2 = ln & 3, srcb = (fr2 + 16 * fq2) << 2;
        const int col2 = col + coff + wc * 32 + 8 * fq2;
        col += coff + wc * 32 + 8 * fq;
        f32x4 s0[2], s1[2];
        if (MODE == 3) {
#pragma unroll
            for (int bj = 0; bj < 2; ++bj) { s0[bj] = *(const f32x4*)(sc + col + bj * 128); s1[bj] = *(const f32x4*)(sc + col + bj * 128 + 4); }
        }
#pragma unroll
        G8_FOR_ROWS {
            bf16_t* rowp = base + (size_t)(u.orow + ai * 128 + wr * 64 + m * 16 + fr2) * ld + col2;
#pragma unroll
            for (int bj = 0; bj < 2; ++bj) {
                f32x4 v0 = acc[ai][bj][m][0], v1 = acc[ai][bj][m][1];
                if (MODE == 1) { if (gel) {
#pragma unroll
                    for (int j = 0; j < 4; ++j) { v0[j] = gelu_fast(v0[j]); v1[j] = gelu_fast(v1[j]); } } }
                if (MODE == 2) { v0 = v0 * mul; v1 = v1 * mul; }
                if (MODE == 3) { v0 = v0 * s0[bj]; v1 = v1 * s1[bj]; }
                *(u32x4*)(rowp + bj * 128) = rowmajor16(pack8(v0, v1), srcb);
            }
        }
    }
};
struct EpiRes {
    const float* hin32; const bf16_t* hin16; bf16_t* hout;
    static constexpr bool HAS_INIT = false, HAS_TILE_INIT = true;
    __device__ __forceinline__ void init_tile(Acc& acc, const Unit& u, int wr, int wc, int fr, int fq) const {
        const int col = u.ocol + wc * 32 + 8 * fq;
#pragma unroll
        G8_FOR_ROWS {
            const size_t ro = (size_t)(u.orow + ai * 128 + wr * 64 + m * 16 + fr) * DM + col;
#pragma unroll
            for (int bj = 0; bj < 2; ++bj) {
                f32x4 h0, h1;
                if (hin32) { h0 = *(const f32x4*)(hin32 + ro + bj * 128); h1 = *(const f32x4*)(hin32 + ro + bj * 128 + 4); }
                else { const u32x4 w = *(const u32x4*)(hin16 + ro + bj * 128);
                    h0[0] = __uint_as_float(w.x << 16); h0[1] = __uint_as_float(w.x & 0xffff0000u); h0[2] = __uint_as_float(w.y << 16); h0[3] = __uint_as_float(w.y & 0xffff0000u);
                    h1[0] = __uint_as_float(w.z << 16); h1[1] = __uint_as_float(w.z & 0xffff0000u); h1[2] = __uint_as_float(w.w << 16); h1[3] = __uint_as_float(w.w & 0xffff0000u); }
                acc[ai][bj][m][0] = h0; acc[ai][bj][m][1] = h1;
            }
        }
    }
    __device__ __forceinline__ void operator()(const Acc& acc, const Unit& u, int wr, int wc, int fr, int fq) const {
        const int ln = fr + 16 * fq, fr2 = ln >> 2, fq2 = ln & 3, srcb = (fr2 + 16 * fq2) << 2;
        const int col = u.ocol + wc * 32 + 8 * fq2;
#pragma unroll
        G8_FOR_ROWS {
            const size_t ro = (size_t)(u.orow + ai * 128 + wr * 64 + m * 16 + fr2) * DM + col;
#pragma unroll
            for (int bj = 0; bj < 2; ++bj) *(u32x4*)(hout + ro + bj * 128) = rowmajor16(pack8(acc[ai][bj][m][0], acc[ai][bj][m][1]), srcb);
        }
    }
};

struct PoolGrpSched {
    int G, c; const char* Wg;
    __device__ __forceinline__ int hB() const { return 128 * 256 * 2; }
    __device__ __forceinline__ bool next(int i, Unit& u) const {
        const int uu = i * G + c; if (uu >= 256) return false;
        const int L = (uu & 7) * 32 + (uu >> 3);
        const int g = L & 3, pm = L >> 2;
        u.a0 = pm * 256; u.orow = pm * 256; u.ocol = g * 256; u.e = g; u.Bb = Wg + (size_t)g * 256 * 256 * 2; return true;
    }
    __device__ __forceinline__ void aoffs(const Unit& u, const int (&R)[2], const int (&C)[2], unsigned (&aoff)[2][2]) const {
#pragma unroll
        for (int h = 0; h < 2; ++h)
#pragma unroll
            for (int i = 0; i < 2; ++i) aoff[h][i] = (unsigned)((u.a0 + h * 128 + R[i]) * DM + u.e * 256 + C[i]) * 2u;
    }
};

constexpr int MOE_TAB_PS = 0, MOE_TAB_CUM = 64, MOE_TAB_UL = 128, MOE_TAB_CNT = 160, MOE_TAB_ROW = 256, MOE_MAXU = 10;
template <int G1> struct MoeSched {
    __device__ __forceinline__ int hB() const { return G1 ? 1024 * 1024 : 128 * 1024; }
    LAS const int* tab; int total, G, c; const char* W; bool xl;
    __device__ __forceinline__ bool search(int i, int& e, int& rt, int& ct) const {
        int wgid;
        if (xl) {
            const int Wd = G1 ? 8 : 4, NR = total / Wd, x = c & 7;
            const int R0 = (x * NR) >> 3, R1 = ((x + 1) * NR) >> 3, off = i * (G >> 3) + (c >> 3);
            if (off >= (R1 - R0) * Wd) return false;
            wgid = R0 * Wd + (G1 ? off : (R1 - R0) * Wd - 1 - off);
        } else {
            const int L = i * G + c; if (L >= total) return false;
            const int q = total / 8, r = total % 8, xcd = L % 8, off = L / 8;
            wgid = (xcd < r ? xcd * (q + 1) : r * (q + 1) + (xcd - r) * q) + off;
        }
        e = 0;
#pragma unroll 1
        for (int j = 1; j < NE; ++j) if (tab[MOE_TAB_CUM + j] <= wgid) e = j;
        const int rem = wgid - tab[MOE_TAB_CUM + e];
        if (G1) { rt = rem >> 3; ct = rem & 7; } else { rt = rem >> 2; ct = rem & 3; }
        return true;
    }
    __device__ __forceinline__ bool decode(int i, int& e, int& rt, int& ct) const {
        if (i >= MOE_MAXU) return false;
        const int v = tab[MOE_TAB_UL + i]; if (v < 0) return false;
        e = v >> 16; rt = (v >> 8) & 255; ct = v & 255; return true;
    }
    __device__ __forceinline__ bool next(int i, Unit& u) const {
        int e, rt, ct; if (!decode(i, e, rt, ct)) return false;
        u.e = e; u.orow = tab[MOE_TAB_PS + e] + rt * 256;
        if (G1) { u.ocol = ct * 128; u.Bb = W + ((size_t)e * 2048 + ct * 128) * 1024; u.a0 = i; }
        else    { u.ocol = ct * 256; u.Bb = W + ((size_t)e * 1024 + ct * 256) * 1024; u.a0 = u.orow; }
        return true;
    }
    __device__ __forceinline__ void aoffs(const Unit& u, const int (&R)[2], const int (&C)[2], unsigned (&aoff)[2][2]) const {
#pragma unroll
        for (int h = 0; h < 2; ++h)
#pragma unroll
            for (int i = 0; i < 2; ++i) {
                const int row = G1 ? tab[MOE_TAB_ROW + u.a0 * 256 + h * 128 + R[i]] : (u.a0 + h * 128 + R[i]);
                aoff[h][i] = (unsigned)(row * DM + C[i] * 2);
            }
    }
};
struct EpiG1 {
    unsigned char* act; const float* bgu;
    static constexpr bool HAS_INIT = true, HAS_TILE_INIT = false;
    __device__ __forceinline__ void load_init(const Unit& u, int wc, int fq, f32x4 (&b)[4]) const {
        const float* bp = bgu + (size_t)u.e * 2048 + u.ocol + wc * 32 + 8 * fq;
        b[0] = *(const f32x4*)bp * SWI_C; b[1] = *(const f32x4*)(bp + 4) * SWI_C; b[2] = *(const f32x4*)(bp + 1024) + 1.0f; b[3] = *(const f32x4*)(bp + 1028) + 1.0f;
    }
    __device__ __forceinline__ void operator()(const Acc& acc, const Unit& u, int wr, int wc, int fr, int fq) const {
        const int col = u.ocol + wc * 32 + 8 * fq;
#pragma unroll
        G8_FOR_ROWS {
            f32x4 o[2];
#pragma unroll
            for (int n = 0; n < 2; ++n) {
                const f32x4 g = acc[ai][0][m][n], up = acc[ai][1][m][n];
#pragma unroll
                for (int jp = 0; jp < 2; ++jp) {
                    f32x2_t gt2, uu2, d2, r2;
#pragma unroll
                    for (int q = 0; q < 2; ++q) {
                        float gt; asm("v_min_f32_e32 %0, %1, %2" : "=v"(gt) : "s"(7.0f * SWI_C), "v"(g[2 * jp + q]));
                        gt2[q] = gt; uu2[q] = __builtin_amdgcn_fmed3f(up[2 * jp + q], -6.0f, 8.0f); d2[q] = __builtin_amdgcn_exp2f(-gt);
                    }
                    d2 = d2 + 1.0f;
                    r2[0] = fast_rcp(d2[0]); r2[1] = fast_rcp(d2[1]);
                    const f32x2_t o2 = (uu2 * gt2) * r2;
                    o[n][2 * jp] = o2[0]; o[n][2 * jp + 1] = o2[1];
                }
            }
            *(u32x2*)(act + (size_t)(u.orow + ai * 128 + wr * 64 + m * 16 + fr) * DM + col) = pack8_fp8_noclamp(o[0], o[1]);
        }
    }
};
}

constexpr int CQ_IDLE_MASK = 3;
constexpr unsigned CQ_TICKS_PER_UNIT = 2400u;
constexpr int CQ_PER_LAYER = 6144, CQ_TOTAL = 4 * CQ_PER_LAYER, CW_QHEAD = 8448;
struct CqJob { const float* src; unsigned char* dst; int N, k0, n0; float sc; };
__device__ __forceinline__ void convq_decode(const Params& p, int q, CqJob& J) {
    const int l = q / CQ_PER_LAYER; int j = q - l * CQ_PER_LAYER;
    if (j < 4096) { const int m = j >> 7, r = j & 127; J.N = 2048; J.k0 = (r >> 3) * 64; J.n0 = (r & 7) * 256;
        J.src = p.in[I_MOE_WGU] + (size_t)(l * NE + m) * 1024 * 2048; J.dst = (p.ws + WT_GU) + (size_t)(l * NE + m) * 2048 * 1024; J.sc = (J.n0 < 1024) ? 32.0f * SWI_C : 32.0f; }
    else { j -= 4096; const int m = j >> 6, r = j & 63; J.N = 1024; J.k0 = (r >> 2) * 64; J.n0 = (r & 3) * 256;
        J.src = p.in[I_MOE_WDN] + (size_t)(l * NE + m) * 1024 * 1024; J.dst = (p.ws + WT_DN) + (size_t)(l * NE + m) * 1024 * 1024; J.sc = 64.0f / SWI_C; }
}
__device__ __forceinline__ void conv_range(const Params& p, unsigned char* smem, int first, int last, int bid, int nblk) {
    const int tidx = tid_opaque(), lane = tidx & 63, kg = tidx >> 6;
    int q = first + bid;
    __syncthreads();
    if (q >= last) return;
    CqJob J, Jn; f32x4 v[8], vn[8];
    convq_decode(p, q, J);
#pragma unroll
    for (int i = 0; i < 8; ++i) v[i] = __builtin_nontemporal_load((const f32x4*)(J.src + (size_t)(J.k0 + kg * 8 + i) * J.N + J.n0 + lane * 4));
#pragma unroll 1
    for (;;) {
        const int qn = q + nblk; const bool hn = qn < last;
        if (hn) {
            convq_decode(p, qn, Jn);
#pragma unroll
            for (int i = 0; i < 8; ++i) vn[i] = __builtin_nontemporal_load((const f32x4*)(Jn.src + (size_t)(Jn.k0 + kg * 8 + i) * Jn.N + Jn.n0 + lane * 4));
        }
#pragma unroll
        for (int i = 0; i < 4; ++i) {
            f32x4 a, b; a[0] = v[0][i] * J.sc; a[1] = v[1][i] * J.sc; a[2] = v[2][i] * J.sc; a[3] = v[3][i] * J.sc; b[0] = v[4][i] * J.sc; b[1] = v[5][i] * J.sc; b[2] = v[6][i] * J.sc; b[3] = v[7][i] * J.sc;
            *(u32x2*)(smem + (lane * 4 + i) * 72 + kg * 8) = g8::pack8_fp8(a, b);
        }
        __syncthreads();
#pragma unroll
        for (int q4 = 0; q4 < 2; ++q4) {
            const int nn = q4 * 128 + (tidx >> 2), ch = tidx & 3;
            u32x4 w; const u32x2 w0 = *(const u32x2*)(smem + nn * 72 + ch * 16), w1 = *(const u32x2*)(smem + nn * 72 + ch * 16 + 8); w.x = w0.x; w.y = w0.y; w.z = w1.x; w.w = w1.y;
            *(u32x4*)(J.dst + (size_t)(J.n0 + nn) * 1024 + J.k0 + ch * 16) = w;
        }
        __syncthreads();
        if (!hn) break;
        q = qn; J = Jn;
#pragma unroll
        for (int i = 0; i < 8; ++i) v[i] = vn[i];
    }
}

constexpr int LDS_MISC_OFF = 64;
template <int G1>
__device__ __forceinline__ void phase_moe_gemm_fast(const Params& p, int layer, unsigned char* smem, int bid, int nblk, bool xl) {
    const int tidx = tid_opaque();
    unsigned char* ws = p.ws;
    LAS int* tab = (LAS int*)(smem + g8::STAGE_BYTES + LDS_MISC_OFF);
    const int* cnt = (const int*)(ws + WS_CTL) + CW_CNT + layer * NE;
    if (tidx < 32) {
        if constexpr (G1 != 0) {
            const int c = cnt[tidx], tiles = (c + 255) >> 8; int incl = tiles;
#pragma unroll
            for (int off = 1; off < 32; off <<= 1) { const int v = __builtin_amdgcn_ds_bpermute((tidx >= off ? tidx - off : tidx) << 2, incl); if (tidx >= off) incl += v; }
            const int excl = incl - tiles;
            tab[g8::MOE_TAB_PS + tidx] = excl << 8; tab[g8::MOE_TAB_CUM + tidx] = excl * 8; tab[g8::MOE_TAB_CNT + tidx] = c;
            if (tidx == 31) { tab[g8::MOE_TAB_PS + NE] = incl << 8; tab[g8::MOE_TAB_CUM + NE] = incl * 8; }
        } else {
            tab[g8::MOE_TAB_CUM + tidx] = (tab[g8::MOE_TAB_PS + tidx] >> 8) * 4;
            if (tidx == 31) tab[g8::MOE_TAB_CUM + NE] = (tab[g8::MOE_TAB_PS + NE] >> 8) * 4;
        }
    }
    __syncthreads();
    g8::MoeSched<G1> S; S.tab = (LAS const int*)tab; S.total = tab[g8::MOE_TAB_CUM + NE]; S.G = nblk; S.c = bid; S.xl = xl;
    S.W = (const char*)(ws + (G1 ? WT_GU : WT_DN)) + (size_t)layer * NE * (G1 ? 2048 : 1024) * 1024;
    if (tidx < g8::MOE_MAXU) { int e, rt, ct; tab[g8::MOE_TAB_UL + tidx] = S.search(tidx, e, rt, ct) ? ((e << 16) | (rt << 8) | ct) : -1; }
    __syncthreads();
    if constexpr (G1 != 0) {
        const int* list = (const int*)(ws + WS_LIST);
#pragma unroll
        for (int j = 0; j < (g8::MOE_MAXU * 256) / 512; ++j) {
            const int idx = tidx + j * 512, i = idx >> 8, r = idx & 255;
            int e, rt, ct;
            if (S.decode(i, e, rt, ct)) { const int ce = tab[g8::MOE_TAB_CNT + e]; int id = rt * 256 + r; id = id < ce ? id : ce - 1; tab[g8::MOE_TAB_ROW + i * 256 + r] = list[e * ECAP + id]; }
        }
        __syncthreads();
        g8::gemm_phase<g8::MoeSched<1>, g8::EpiG1, 1>((LAS unsigned char*)smem, (const char*)(ws + WS_U8), DM, DM / 128, S, g8::EpiG1{(unsigned char*)(ws + WS_ACT), p.in[I_MOE_BGU] + (size_t)layer * NE * 2048}, 0x7A7A7A7A);
    } else {
        g8::gemm_phase<g8::MoeSched<0>, g8::EpiB<4>, 1>((LAS unsigned char*)smem, (const char*)(ws + WS_ACT), DM, DM / 128, S, g8::EpiB<4>{(bf16_t*)(ws + WS_YS), nullptr, nullptr, p.in[I_MOE_BDN] + (size_t)layer * NE * 1024, 0.f, DM, 0}, 0x7D7D7D7D);
    }
    if (layer < 3) {
        int mine = 0;
#pragma unroll
        for (int i = 0; i < g8::MOE_MAXU; ++i) mine += (tab[g8::MOE_TAB_UL + i] >= 0) ? 1 : 0;
        mine = __builtin_amdgcn_readfirstlane(mine);
        int maxu = (S.total + nblk - 1) / nblk;
        if (xl) { const int Wd = G1 ? 8 : 4, NR = S.total / Wd, x = bid & 7; maxu = ((((x + 1) * NR) >> 3) - ((x * NR) >> 3)) * Wd; maxu = (maxu + (nblk >> 3) - 1) / (nblk >> 3); }
        const int target = layer + 1, tb = (target % 3 == 0) ? 2048 : 0;
        int* qh = (int*)(ws + WS_CTL) + CW_QHEAD + target;
        LAS int* slot = (LAS int*)(smem + g8::STAGE_BYTES + 48);
#pragma unroll 1
        for (int k = 0; k < (maxu - mine) * 3; ++k) {
            __syncthreads();
            if (tidx == 0) *slot = atomicAdd(qh, 2);
            __syncthreads();
            const int u = __builtin_amdgcn_readfirstlane(*slot) + tb;
            if (u >= CQ_PER_LAYER) break;
            conv_range(p, smem, target * CQ_PER_LAYER + u, target * CQ_PER_LAYER + (u + 2 < CQ_PER_LAYER ? u + 2 : CQ_PER_LAYER), 0, 1);
        }
    }
}
__device__ __forceinline__ void phase_lru_mid(const Params& p, int slot, unsigned char* smem, int bid, int nblk) {
    const int tid = tid_opaque(), wid = __builtin_amdgcn_readfirstlane(tid >> 6), lane = tid & 63, r32 = lane & 31, hi = lane >> 5;
    unsigned char* ws = p.ws;
    const bf16_t* XBP = (const bf16_t*)(ws + WS_B1); const bf16_t* GG = (const bf16_t*)(ws + WS_B0); bf16_t* Y = (bf16_t*)(ws + WS_B3);
    LAS unsigned char* Al = (LAS unsigned char*)smem;
    LAS float* wAB = (LAS float*)(smem + 69632);
    LAS float* cwl = (LAS float*)(smem + 69632 + 2048);
    LAS unsigned char* wfl = (LAS unsigned char*)(smem + 69632 + 2048 + 2560);
    unsigned char* cvl = smem + 98304;
    const int chunk = tid & 15, rg = tid >> 4;
#pragma unroll 1
    for (int uu = bid; uu < 256; uu += nblk) {
        const int unit = (uu & 7) * 32 + (uu >> 3);
        const int b = unit >> 5, g = (unit >> 2) & 7, s = unit & 3;
        const int c = g * 128 + s * 32 + r32;
        __syncthreads();
        if (tid < 128) {
#pragma unroll
            for (int k = 0; k < 4; ++k) cwl[k * 128 + tid] = p.in[I_LRU_CW][(size_t)(slot * 4 + k) * DM + g * 128 + tid];
            cwl[4 * 128 + tid] = p.in[I_LRU_CB][(size_t)slot * DM + g * 128 + tid];
        }
        if (tid < 64) {
            const bf16_t* wap = (const bf16_t*)(ws + WT_LRU_A) + ((size_t)(slot * 8 + g) * 128 + s * 32 + r32) * 128 + hi * 8;
            const bf16_t* wxp = (const bf16_t*)(ws + WT_LRU_X) + ((size_t)(slot * 8 + g) * 128 + s * 32 + r32) * 128 + hi * 8;
#pragma unroll
            for (int st = 0; st < 8; ++st) { *(LAS bf16x8*)(wfl + (st * 64 + lane) * 16) = *(const bf16x8*)(wap + st * 16); *(LAS bf16x8*)(wfl + ((8 + st) * 64 + lane) * 16) = *(const bf16x8*)(wxp + st * 16); }
        }
        const float ba = p.in[I_LRU_BA][(size_t)slot * DM + c], bx = p.in[I_LRU_BX][(size_t)slot * DM + c];
        const float ca = -8.0f * log1pf(__expf(-p.in[I_LRU_AP][(size_t)slot * DM + c]));
        const float L2E = 1.4426950408889634f, ba2 = -ba * L2E, bx2 = -bx * L2E, ca2 = ca * L2E;
        float hcar = 0.f;
        __syncthreads();
        const int cq0 = slot * 3 * CQ_PER_LAYER + unit * 8;
#pragma unroll 1
        for (int rt = 0; rt < 8; ++rt) {
            const int t0 = b * SEQ + rt * 256;
            u32x4 xr[11];
            {
                const bf16_t* xp = XBP + (size_t)(t0 + rg * 8 - 3) * DM + g * 128 + chunk * 8;
                const bool head = (rt == 0 && rg == 0);
#pragma unroll
                for (int i = 0; i < 11; ++i) { if (i < 3 && head) xr[i] = (u32x4){0u, 0u, 0u, 0u}; else xr[i] = *(const u32x4*)(xp + (size_t)i * DM); }
            }
            const int cq = cq0 + rt; const bool cvalid = true; CqJob CJ; f32x4 cv[8];
            if (cvalid) { convq_decode(p, cq, CJ);
#pragma unroll
                for (int i = 0; i < 8; ++i) cv[i] = __builtin_nontemporal_load((const f32x4*)(CJ.src + (size_t)(CJ.k0 + wid * 8 + i) * CJ.N + CJ.n0 + lane * 4)); }
            bf16_t ggv[16];
#pragma unroll
            for (int r = 0; r < 16; ++r) ggv[r] = GG[(size_t)(t0 + 32 * wid + crow(r, hi)) * DM + c];
            {
                f32x4 w0[4], w1[4];
#pragma unroll
                for (int k = 0; k < 4; ++k) { w0[k] = *(const LAS f32x4*)(cwl + k * 128 + chunk * 8); w1[k] = *(const LAS f32x4*)(cwl + k * 128 + chunk * 8 + 4); }
                const f32x4 bb0 = *(const LAS f32x4*)(cwl + 4 * 128 + chunk * 8), bb1 = *(const LAS f32x4*)(cwl + 4 * 128 + chunk * 8 + 4);
#pragma unroll
                for (int i = 0; i < 8; ++i) {
                    f32x4 o0 = bb0, o1 = bb1;
#pragma unroll
                    for (int k = 0; k < 4; ++k) {
                        const u32x4 x = xr[i + k];
                        f32x4 x0, x1;
                        x0[0] = __uint_as_float(x.x << 16); x0[1] = __uint_as_float(x.x & 0xffff0000u); x0[2] = __uint_as_float(x.y << 16); x0[3] = __uint_as_float(x.y & 0xffff0000u);
                        x1[0] = __uint_as_float(x.z << 16); x1[1] = __uint_as_float(x.z & 0xffff0000u); x1[2] = __uint_as_float(x.w << 16); x1[3] = __uint_as_float(x.w & 0xffff0000u);
                        o0 = o0 + x0 * w0[k]; o1 = o1 + x1 * w1[k];
                    }
                    *(LAS u32x4*)(Al + (rg * 8 + i) * 272 + chunk * 16) = g8::pack8(o0, o1);
                }
            }
            __syncthreads();
            f32x16 ar = {}, ax = {};
#pragma unroll
            for (int st = 0; st < 8; ++st) {
                const bf16x8 a = *(const LAS bf16x8*)(Al + (32 * wid + r32) * 272 + st * 32 + hi * 16);
                ar = __builtin_amdgcn_mfma_f32_32x32x16_bf16(a, *(const LAS bf16x8*)(wfl + (st * 64 + lane) * 16), ar, 0, 0, 0);
                ax = __builtin_amdgcn_mfma_f32_32x32x16_bf16(a, *(const LAS bf16x8*)(wfl + ((8 + st) * 64 + lane) * 16), ax, 0, 0, 0);
            }
            float av[16], bv[16];
#pragma unroll
            for (int r = 0; r < 16; ++r) {
                const float xb = bf2f(*(const LAS bf16_t*)(Al + (32 * wid + crow(r, hi)) * 272 + (s * 32 + r32) * 2));
                const float rgt = g8::fast_rcp(1.0f + __builtin_amdgcn_exp2f(__builtin_fmaf(ar[r], -L2E, ba2))), igt = g8::fast_rcp(1.0f + __builtin_amdgcn_exp2f(__builtin_fmaf(ax[r], -L2E, bx2)));
                const float a = __builtin_amdgcn_exp2f(ca2 * rgt);
                av[r] = a; bv[r] = __builtin_amdgcn_sqrtf(fmaxf(__builtin_fmaf(-a, a, 1.0f), 0.f)) * (igt * xb);
            }
            float GA[4], GB[4], PA[4], PB[4];
#pragma unroll
            for (int gi = 0; gi < 4; ++gi) {
                float A = av[4 * gi], Bq = bv[4 * gi];
#pragma unroll
                for (int k = 1; k < 4; ++k) { Bq = av[4 * gi + k] * Bq + bv[4 * gi + k]; A = av[4 * gi + k] * A; }
                GA[gi] = A; GB[gi] = Bq; PA[gi] = shx(A, 32, lane); PB[gi] = shx(Bq, 32, lane);
            }
            float TA = 1.f, TB = 0.f;
#pragma unroll
            for (int gi = 0; gi < 4; ++gi) {
                const float loA = hi ? PA[gi] : GA[gi], loB = hi ? PB[gi] : GB[gi], hiA = hi ? GA[gi] : PA[gi], hiB = hi ? GB[gi] : PB[gi];
                TB = loA * TB + loB; TA = loA * TA; TB = hiA * TB + hiB; TA = hiA * TA;
            }
            if (hi == 0) { wAB[(wid * 32 + r32) * 2] = TA; wAB[(wid * 32 + r32) * 2 + 1] = TB; }
            if (cvalid) {
#pragma unroll
                for (int i = 0; i < 4; ++i) {
                    f32x4 a, bq; a[0] = cv[0][i] * CJ.sc; a[1] = cv[1][i] * CJ.sc; a[2] = cv[2][i] * CJ.sc; a[3] = cv[3][i] * CJ.sc; bq[0] = cv[4][i] * CJ.sc; bq[1] = cv[5][i] * CJ.sc; bq[2] = cv[6][i] * CJ.sc; bq[3] = cv[7][i] * CJ.sc;
                    *(u32x2*)(cvl + (lane * 4 + i) * 72 + wid * 8) = g8::pack8_fp8(a, bq);
                }
            }
            __syncthreads();
            if (cvalid) {
#pragma unroll
                for (int q4 = 0; q4 < 2; ++q4) {
                    const int nn = q4 * 128 + (tid >> 2), ch = tid & 3;
                    u32x4 w; const u32x2 w0 = *(const u32x2*)(cvl + nn * 72 + ch * 16), w1 = *(const u32x2*)(cvl + nn * 72 + ch * 16 + 8); w.x = w0.x; w.y = w0.y; w.z = w1.x; w.w = w1.y;
                    *(u32x4*)(CJ.dst + (size_t)(CJ.n0 + nn) * 1024 + CJ.k0 + ch * 16) = w;
                }
            }
            float hin = hcar, hall = hcar;
#pragma unroll
            for (int w = 0; w < 8; ++w) {
                const float A = wAB[(w * 32 + r32) * 2], Bq = wAB[(w * 32 + r32) * 2 + 1];
                hall = A * hall + Bq; if (w < wid) hin = hall;
            }
            hcar = hall;
            float h = hin;
#pragma unroll
            for (int gi = 0; gi < 4; ++gi) {
                const float loA = hi ? PA[gi] : GA[gi], loB = hi ? PB[gi] : GB[gi], hiA = hi ? GA[gi] : PA[gi], hiB = hi ? GB[gi] : PB[gi];
                const float hlo = h, hhi = loA * h + loB;
                h = hiA * hhi + hiB;
                float hh = hi ? hhi : hlo;
#pragma unroll
                for (int k = 0; k < 4; ++k) {
                    hh = av[4 * gi + k] * hh + bv[4 * gi + k];
                    Y[(size_t)(t0 + 32 * wid + crow(4 * gi + k, hi)) * DM + c] = f2bf(hh * bf2f(ggv[4 * gi + k]));
                }
            }
        }
    }
}

__device__ __forceinline__ void phase_moe_route_fast(const Params& p, int layer, unsigned char* smem, int bid, int nblk) {
    const int tid = tid_opaque(), wid = __builtin_amdgcn_readfirstlane(tid >> 6), lane = tid & 63, r32 = lane & 31, hi = lane >> 5;
    unsigned char* ws = p.ws;
    const bf16_t* H = (const bf16_t*)(ws + WS_H); unsigned char* U8 = ws + WS_U8;
    const float* g = p.in[I_FFNN] + (size_t)layer * DM; const float* br = p.in[I_MOE_BR] + (size_t)layer * NE;
    const bf16_t* WrT = (const bf16_t*)(ws + WT_ROUTER) + (size_t)layer * NE * DM;
    int* cnt = (int*)(ws + WS_CTL) + CW_CNT + layer * NE; int* list = (int*)(ws + WS_LIST); int* tokslot = (int*)(ws + WS_TOKSLOT); float* gates = (float*)(ws + WS_GATES);
    LAS unsigned char* Ut = (LAS unsigned char*)smem;
    LAS float* part = (LAS float*)(smem + 66048);
    LAS float* lgt = (LAS float*)(smem + 66048 + 32768);
    LAS int* pick_e = (LAS int*)(smem + 66048 + 32768 + 8704);
    LAS int* pick_p = pick_e + 256;
    LAS float* pick_g = (LAS float*)(pick_p + 256);
    LAS int* lcnt = (LAS int*)(pick_g + 256);
#pragma unroll 1
    for (int uu = bid; uu < 256; uu += nblk) {
        const int base = (uu & 7) * 2048 + (uu >> 3) * 64;
        __syncthreads();
        if (tid < 32) lcnt[tid] = 0;
        bf16x8 bw[8];
#pragma unroll
        for (int st = 0; st < 8; ++st) bw[st] = *(const bf16x8*)(WrT + (size_t)r32 * DM + wid * 128 + st * 16 + hi * 8);
        f32x4 gg[4];
#pragma unroll
        for (int q = 0; q < 4; ++q) gg[q] = *(const f32x4*)(g + q * 256 + lane * 4);
        u32x2 hw[4][4], hn[4][4];
#pragma unroll
        for (int j = 0; j < 4; ++j)
#pragma unroll
            for (int q = 0; q < 4; ++q) hw[j][q] = *(const u32x2*)(H + (size_t)(base + wid * 4 + j) * DM + q * 256 + lane * 4);
#pragma unroll
        for (int pass = 0; pass < 2; ++pass) {
            const int tok0 = base + pass * 32;
            if (pass == 0) {
#pragma unroll
                for (int j = 0; j < 4; ++j)
#pragma unroll
                    for (int q = 0; q < 4; ++q) hn[j][q] = *(const u32x2*)(H + (size_t)(base + 32 + wid * 4 + j) * DM + q * 256 + lane * 4);
            }
#pragma unroll
            for (int j = 0; j < 4; ++j) {
                const int row = wid * 4 + j;
                f32x4 v[4]; float ss = 0.f;
#pragma unroll
                for (int q = 0; q < 4; ++q) { const u32x2 w = hw[j][q];
                    v[q][0] = __uint_as_float(w.x << 16); v[q][1] = __uint_as_float(w.x & 0xffff0000u); v[q][2] = __uint_as_float(w.y << 16); v[q][3] = __uint_as_float(w.y & 0xffff0000u);
                    ss += v[q][0] * v[q][0] + v[q][1] * v[q][1] + v[q][2] * v[q][2] + v[q][3] * v[q][3]; }
                ss = wave_sum(ss, lane);
                const float rstd = rsqrtf(ss * (1.0f / 1024.0f) + RMS_EPS);
#pragma unroll
                for (int q = 0; q < 4; ++q) {
                    f32x4 un; un[0] = v[q][0] * rstd * gg[q][0]; un[1] = v[q][1] * rstd * gg[q][1]; un[2] = v[q][2] * rstd * gg[q][2]; un[3] = v[q][3] * rstd * gg[q][3];
                    u32x2 w; w.x = pk2(un[0], un[1]); w.y = pk2(un[2], un[3]);
                    *(LAS u32x2*)(Ut + row * 2064 + (q * 256 + lane * 4) * 2) = w;
                    int w8 = 0; w8 = __builtin_amdgcn_cvt_pk_fp8_f32(g8::clamp448(un[0]), g8::clamp448(un[1]), w8, false); w8 = __builtin_amdgcn_cvt_pk_fp8_f32(g8::clamp448(un[2]), g8::clamp448(un[3]), w8, true);
                    *(int*)(U8 + (size_t)(tok0 + row) * DM + q * 256 + lane * 4) = w8;
                }
            }
            __syncthreads();
            f32x16 acc = {};
#pragma unroll
            for (int st = 0; st < 8; ++st) {
                const int k = wid * 128 + st * 16 + hi * 8;
                const bf16x8 a = *(const LAS bf16x8*)(Ut + r32 * 2064 + k * 2);
                acc = __builtin_amdgcn_mfma_f32_32x32x16_bf16(a, bw[st], acc, 0, 0, 0);
            }
#pragma unroll
            for (int r = 0; r < 16; ++r) part[(wid * 16 + r) * 64 + lane] = acc[r];
            __syncthreads();
#pragma unroll
            for (int o2 = 0; o2 < 2; ++o2) {
                const int o = tid + o2 * 512, r = o >> 6, l = o & 63;
                float s = 0.f;
#pragma unroll
                for (int w = 0; w < 8; ++w) s += part[(w * 16 + r) * 64 + l];
                lgt[pass * 1088 + crow(r, l >> 5) * 33 + (l & 31)] = s + br[l & 31];
            }
            if (pass == 0) {
#pragma unroll
                for (int j = 0; j < 4; ++j)
#pragma unroll
                    for (int q = 0; q < 4; ++q) hw[j][q] = hn[j][q];
            }
        }
        __syncthreads();
        if (tid < 64) {
            float lg[NE];
#pragma unroll
            for (int e = 0; e < NE; ++e) lg[e] = lgt[(tid >> 5) * 1088 + (tid & 31) * 33 + e];
            unsigned used = 0u; float bv[4]; int bi[4];
#pragma unroll
            for (int k = 0; k < TOPK; ++k) {
                float best = -INFINITY; int idx = 0;
#pragma unroll
                for (int e = 0; e < NE; ++e) { const bool ok = !((used >> e) & 1u) && (lg[e] > best); best = ok ? lg[e] : best; idx = ok ? e : idx; }
                used |= 1u << idx; bv[k] = best; bi[k] = idx;
            }
            float w[4], wsum = 0.f;
#pragma unroll
            for (int k = 0; k < TOPK; ++k) { w[k] = __expf(bv[k] - bv[0]); wsum += w[k]; }
            const float inv = 1.0f / wsum;
#pragma unroll
            for (int k = 0; k < TOPK; ++k) {
                const int slot = tid * 4 + k;
                pick_e[slot] = bi[k]; pick_g[slot] = w[k] * inv;
                pick_p[slot] = __hip_atomic_fetch_add(&lcnt[bi[k]], 1, __ATOMIC_RELAXED, __HIP_MEMORY_SCOPE_WORKGROUP);
            }
        }
        __syncthreads();
        if (tid < 32) { const int n = lcnt[tid]; lcnt[32 + tid] = n ? atomicAdd(&cnt[tid], n) : 0; }
        __syncthreads();
        if (tid < 256) {
            const int tl = tid >> 2, e = pick_e[tid], pos = lcnt[32 + e] + pick_p[tid], t = base + tl;
            list[e * ECAP + pos] = t; tokslot[t * 4 + (tid & 3)] = (e << 16) | pos; gates[t * 4 + (tid & 3)] = pick_g[tid];
        }
    }
}

__device__ __forceinline__ void phase_moe_comb_fast(const Params& p, int layer, unsigned char* smem, int bid, int nblk) {
    const int tid = tid_opaque(), wid = __builtin_amdgcn_readfirstlane(tid >> 6), lane = tid & 63;
    unsigned char* ws = p.ws;
    const int* cnt = (const int*)(ws + WS_CTL) + CW_CNT + layer * NE;
    LAS const int* ps = (LAS const int*)(smem + g8::STAGE_BYTES + LDS_MISC_OFF) + g8::MOE_TAB_PS;
    bf16_t* H = (bf16_t*)(ws + WS_H); unsigned char* U = ws + WS_U; const unsigned char* YS = ws + WS_YS;
    const int* tokslot = (const int*)(ws + WS_TOKSLOT); const float* gates = (const float*)(ws + WS_GATES);
    const bool last = (layer == 3);
    const float* g = last ? p.in[I_FINN] : p.in[I_MIXN] + (size_t)(layer + 1) * DM;
    f32x4 gg[2][2];
#pragma unroll
    for (int sg = 0; sg < 2; ++sg) { gg[sg][0] = *(const f32x4*)(g + sg * 512 + lane * 8); gg[sg][1] = *(const f32x4*)(g + sg * 512 + lane * 8 + 4); }
    auto tok_at = [&](int q) __attribute__((always_inline)) { const int uu = bid + (q >> 2) * nblk; return uu < 256 ? (uu & 7) * 2048 + (uu >> 3) * 64 + (q & 3) * 16 + wid * 2 : -1; };
    int slv = 0; float gwv = 0.f;
    { const int tf = tok_at(0); if (tf >= 0) { slv = tokslot[tf * 4 + (lane & 7)]; gwv = gates[tf * 4 + (lane & 7)]; } }
#pragma unroll 1
    for (int q = 0; ; ++q) {
        const int t0 = tok_at(q); if (t0 < 0) break;
        f32x4 v[2][2][2]; u32x2 y[2][4][2]; float gw[2][4];
        const int slc = slv; const float gwc = gwv;
        { const int tn = tok_at(q + 1); if (tn >= 0) { slv = tokslot[tn * 4 + (lane & 7)]; gwv = gates[tn * 4 + (lane & 7)]; } }
#pragma unroll
        for (int a = 0; a < 2; ++a) {
            const int t = t0 + a;
            const bf16_t* hrow = H + (size_t)t * DM;
#pragma unroll
            for (int sg = 0; sg < 2; ++sg) { const u32x4 w = *(const u32x4*)(hrow + sg * 512 + lane * 8);
                v[a][sg][0][0] = __uint_as_float(w.x << 16); v[a][sg][0][1] = __uint_as_float(w.x & 0xffff0000u); v[a][sg][0][2] = __uint_as_float(w.y << 16); v[a][sg][0][3] = __uint_as_float(w.y & 0xffff0000u);
                v[a][sg][1][0] = __uint_as_float(w.z << 16); v[a][sg][1][1] = __uint_as_float(w.z & 0xffff0000u); v[a][sg][1][2] = __uint_as_float(w.w << 16); v[a][sg][1][3] = __uint_as_float(w.w & 0xffff0000u); }
#pragma unroll
            for (int k = 0; k < TOPK; ++k) {
                const int sl = __builtin_amdgcn_readlane(slc, a * 4 + k); gw[a][k] = __int_as_float(__builtin_amdgcn_readlane(__float_as_int(gwc), a * 4 + k)) * 0.0625f;
                const unsigned char* yr = YS + (size_t)(ps[sl >> 16] + (sl & 0xffff)) * DM;
#pragma unroll
                for (int sg = 0; sg < 2; ++sg) y[a][k][sg] = *(const u32x2*)(yr + sg * 512 + lane * 8);
            }
        }
#pragma unroll
        for (int a = 0; a < 2; ++a) {
            const int t = t0 + a;
            float ss = 0.f;
#pragma unroll
            for (int sg = 0; sg < 2; ++sg) {
#pragma unroll
                for (int k = 0; k < TOPK; ++k) {
                    const u32x2 w = y[a][k][sg]; const float q = gw[a][k];
                    const f32x2_t p0 = __builtin_amdgcn_cvt_pk_f32_fp8((int)w.x, false), p1 = __builtin_amdgcn_cvt_pk_f32_fp8((int)w.x, true);
                    const f32x2_t p2 = __builtin_amdgcn_cvt_pk_f32_fp8((int)w.y, false), p3 = __builtin_amdgcn_cvt_pk_f32_fp8((int)w.y, true);
                    v[a][sg][0][0] += q * p0[0]; v[a][sg][0][1] += q * p0[1]; v[a][sg][0][2] += q * p1[0]; v[a][sg][0][3] += q * p1[1];
                    v[a][sg][1][0] += q * p2[0]; v[a][sg][1][1] += q * p2[1]; v[a][sg][1][2] += q * p3[0]; v[a][sg][1][3] += q * p3[1];
                }
#pragma unroll
                for (int hh = 0; hh < 2; ++hh)
#pragma unroll
                    for (int j = 0; j < 4; ++j) ss += v[a][sg][hh][j] * v[a][sg][hh][j];
            }
            ss = wave_sum(ss, lane);
            const float rstd = rsqrtf(ss * (1.0f / 1024.0f) + RMS_EPS);
#pragma unroll
            for (int sg = 0; sg < 2; ++sg) {
                const f32x4 o0 = v[a][sg][0] * rstd * gg[sg][0], o1 = v[a][sg][1] * rstd * gg[sg][1];
                if (last) {
                    *(f32x4*)(p.out + (size_t)t * DM + sg * 512 + lane * 8) = o0; *(f32x4*)(p.out + (size_t)t * DM + sg * 512 + lane * 8 + 4) = o1;
                } else {
                    *(u32x4*)(H + (size_t)t * DM + sg * 512 + lane * 8) = g8::pack8(v[a][sg][0], v[a][sg][1]);
                    *(u32x2*)(U + (size_t)t * DM + sg * 512 + lane * 8) = g8::pack8_fp8(o0, o1);
                }
            }
        }
    }
}

__device__ __forceinline__ void phase_sb_attn_fast(const Params& p, int bid, int nblk) {
    const int tid = tid_opaque(), wid = __builtin_amdgcn_readfirstlane(tid >> 6), lane = tid & 63, r32 = lane & 31, hi = lane >> 5;
    unsigned char* ws = p.ws;
    const bf16_t* Q = (const bf16_t*)(ws + WS_B0); const bf16_t* Kp = (const bf16_t*)(ws + WS_B1); const bf16_t* V = (const bf16_t*)(ws + WS_B2); bf16_t* O = (bf16_t*)(ws + WS_B3);
#pragma unroll 1
    for (int uu = bid; uu < 256; uu += nblk)
#pragma unroll 1
    for (int k4 = 0; k4 < 4; ++k4) {
        const int unit = (uu & 7) * 1024 + k4 * 256 + (uu >> 3) * 8 + wid;
        const int qb = unit & 63, h = (unit >> 6) & 15, b = unit >> 10;
        const int q0 = qb * 32; const size_t tb = (size_t)b * SEQ;
        bf16x8 qf[4];
#pragma unroll
        for (int st = 0; st < 4; ++st) qf[st] = *(const bf16x8*)(Q + (tb + q0 + r32) * DM + h * HD + st * 16 + hi * 8);
        f32x16 o0 = {}, o1 = {};
        float carry = 1.0f;
        bf16x8 kf[4];
        {
            const bf16_t* kp = Kp + (tb + q0 + r32) * DM + h * HD + hi * 8;
#pragma unroll
            for (int st = 0; st < 4; ++st) kf[st] = *(const bf16x8*)(kp + st * 16);
        }
#pragma unroll 1
        for (int kt = qb; kt >= 0; --kt) {
            const int kbase = kt * 32;
            bf16x8 vf[2][2];
            {
                const bf16_t* vp = V + (tb + kbase + 4 * hi) * DM + h * HD + r32;
#pragma unroll
                for (int s = 0; s < 2; ++s)
#pragma unroll
                    for (int d0 = 0; d0 < 2; ++d0)
#pragma unroll
                        for (int j = 0; j < 8; ++j) vf[s][d0][j] = (short)vp[(size_t)(16 * s + 8 * (j >> 2) + (j & 3)) * DM + d0 * 32];
            }
            f32x16 sc = {};
#pragma unroll
            for (int st = 0; st < 4; ++st) sc = __builtin_amdgcn_mfma_f32_32x32x16_bf16(kf[st], qf[st], sc, 0, 0, 0);
            if (kt > 0) {
                const bf16_t* kp = Kp + (tb + kbase - 32 + r32) * DM + h * HD + hi * 8;
#pragma unroll
                for (int st = 0; st < 4; ++st) kf[st] = *(const bf16x8*)(kp + st * 16);
            }
            float rr[16];
#pragma unroll
            for (int r = 0; r < 16; ++r) {
                const float e = __builtin_amdgcn_exp2f(sc[r]);
                float x = __builtin_amdgcn_rcpf(1.0f + e);
                if (kt == qb) x = (crow(r, hi) < r32) ? x : 1.0f;
                rr[r] = x;
            }
            float G[4], P[4];
#pragma unroll
            for (int gi = 0; gi < 4; ++gi) { G[gi] = (rr[4 * gi] * rr[4 * gi + 1]) * (rr[4 * gi + 2] * rr[4 * gi + 3]); P[gi] = shx(G[gi], 32, lane); }
            float cur = carry, av[16];
#pragma unroll
            for (int gi = 3; gi >= 0; --gi) {
                const float hiP = hi ? G[gi] : P[gi], loP = hi ? P[gi] : G[gi];
                const float ent_hi = cur; cur *= hiP; const float ent_lo = cur; cur *= loP;
                float s_cur = hi ? ent_hi : ent_lo;
#pragma unroll
                for (int k = 3; k >= 0; --k) { const float s_next = s_cur * rr[4 * gi + k]; av[4 * gi + k] = s_cur - s_next; s_cur = s_next; }
            }
            carry = cur;
            bf16x8 pf[2];
#pragma unroll
            for (int s = 0; s < 2; ++s) {
                u32x4 w; w.x = pk2(av[8 * s], av[8 * s + 1]); w.y = pk2(av[8 * s + 2], av[8 * s + 3]); w.z = pk2(av[8 * s + 4], av[8 * s + 5]); w.w = pk2(av[8 * s + 6], av[8 * s + 7]);
                pf[s] = __builtin_bit_cast(bf16x8, w);
            }
            o0 = __builtin_amdgcn_mfma_f32_32x32x16_bf16(pf[0], vf[0][0], o0, 0, 0, 0);
            o1 = __builtin_amdgcn_mfma_f32_32x32x16_bf16(pf[0], vf[0][1], o1, 0, 0, 0);
            o0 = __builtin_amdgcn_mfma_f32_32x32x16_bf16(pf[1], vf[1][0], o0, 0, 0, 0);
            o1 = __builtin_amdgcn_mfma_f32_32x32x16_bf16(pf[1], vf[1][1], o1, 0, 0, 0);
            if (__all(carry == 0.0f)) break;
        }
#pragma unroll
        for (int r = 0; r < 16; ++r) {
            bf16_t* op = O + (tb + q0 + crow(r, hi)) * DM + h * HD + r32;
            op[0] = f2bf(o0[r]); op[32] = f2bf(o1[r]);
        }
    }
}

__device__ __forceinline__ void unpack8(const u32x4& x, float (&f)[8]) {
    f[0] = __uint_as_float(x.x << 16); f[1] = __uint_as_float(x.x & 0xffff0000u); f[2] = __uint_as_float(x.y << 16); f[3] = __uint_as_float(x.y & 0xffff0000u);
    f[4] = __uint_as_float(x.z << 16); f[5] = __uint_as_float(x.z & 0xffff0000u); f[6] = __uint_as_float(x.w << 16); f[7] = __uint_as_float(x.w & 0xffff0000u);
}
template <int WIN>
__device__ __forceinline__ void pool_tile_w(const Params& p, int pm, int g) {
    const int tid = tid_opaque();
    unsigned char* ws = p.ws;
    const bf16_t* v = (const bf16_t*)(ws + WS_B0); bf16_t* pb = (bf16_t*)(ws + WS_B1);
    const int chunk = tid & 31, rb = tid >> 5;
    const int c0 = g * 256 + chunk * 8;
#pragma unroll 1
    for (int half = 0; half < 2; ++half) {
        const int t0 = pm * 256 + rb * 16 + half * 8, pos0 = t0 & (SEQ - 1);
        u32x4 rows[WIN - 1 + 8];
#pragma unroll
        for (int i = 0; i < WIN - 1 + 8; ++i) {
            const int d = i - (WIN - 1);
            if (pos0 + d >= 0) rows[i] = *(const u32x4*)(v + (size_t)(t0 + d) * DM + c0); else rows[i] = (u32x4){0u, 0u, 0u, 0u};
        }
        float s[8];
#pragma unroll
        for (int j = 0; j < 8; ++j) s[j] = 0.f;
#pragma unroll
        for (int i = 0; i < WIN - 1; ++i) { float f[8]; unpack8(rows[i], f);
#pragma unroll
            for (int j = 0; j < 8; ++j) s[j] += f[j]; }
#pragma unroll
        for (int i = 0; i < 8; ++i) {
            const int pos = pos0 + i;
            float xv[8]; unpack8(rows[WIN - 1 + i], xv);
#pragma unroll
            for (int j = 0; j < 8; ++j) s[j] += xv[j];
            const int n = pos + 1 < WIN ? pos + 1 : WIN; const float inv = g8::fast_rcp((float)n); const float inv2 = inv * (2.0f - (float)n * inv);
            f32x4 o0, o1;
#pragma unroll
            for (int j = 0; j < 4; ++j) { o0[j] = s[j] * inv2 - xv[j]; o1[j] = s[4 + j] * inv2 - xv[4 + j]; }
            *(u32x4*)(pb + (size_t)(t0 + i) * DM + c0) = g8::pack8(o0, o1);
            float lv[8]; unpack8(rows[i], lv);
#pragma unroll
            for (int j = 0; j < 8; ++j) s[j] -= lv[j];
        }
    }
    asm volatile("s_waitcnt vmcnt(0)" ::: "memory");
    __syncthreads();
}
__device__ __forceinline__ void pool_tile(const Params& p, int pm, int g) {
    if (g == 0) pool_tile_w<2>(p, pm, g); else if (g == 1) pool_tile_w<4>(p, pm, g); else if (g == 2) pool_tile_w<8>(p, pm, g); else pool_tile_w<16>(p, pm, g);
}

__device__ __forceinline__ unsigned char* opq(unsigned char* q) {
    const unsigned long long v = (unsigned long long)q;
    unsigned lo = (unsigned)__builtin_amdgcn_readfirstlane((int)(unsigned)v), hi = (unsigned)__builtin_amdgcn_readfirstlane((int)(unsigned)(v >> 32));
    asm volatile("" : "+s"(lo), "+s"(hi));
    return (unsigned char*)(((unsigned long long)hi << 32) | lo);
}
#define XB_TMO      128
#define XB_XCNT(j)  (256  + 64 * (j))
#define XB_XSUB(j)  (1280 + 64 * (j))
#define XB_XGEN(j)  (2304 + 64 * (j))
#define XB_TOP      3328
#define XB_TOPGEN   3392
#define XCD_BAR_WORDS 3456
#define XB_SPIN_CAP (1u << 21)
__device__ __forceinline__ unsigned xb_ld(unsigned* p)              { return __hip_atomic_load(p, __ATOMIC_RELAXED, __HIP_MEMORY_SCOPE_AGENT); }
__device__ __forceinline__ unsigned xb_add(unsigned* p, unsigned v) { return __hip_atomic_fetch_add(p, v, __ATOMIC_RELAXED, __HIP_MEMORY_SCOPE_AGENT); }
__device__ __forceinline__ unsigned xb_xcc_id() { return (unsigned)__builtin_amdgcn_s_getreg((3 << 11) | 20) & 0xFu; }
#define XB_SPIN(cond, bar) do { unsigned _sp = 0; while (cond) { __builtin_amdgcn_s_sleep(1); \
    if ((++_sp & 255u) == 0u) { if (xb_ld(&(bar)[XB_TMO])) break; if (_sp > XB_SPIN_CAP) { atomicAdd(&(bar)[XB_TMO], 1u); break; } } } } while (0)
struct XcdBarrier { unsigned* bar; unsigned x; volatile LAS unsigned* st; };
__device__ __forceinline__ XcdBarrier xcd_barrier_post(unsigned* bar, volatile LAS unsigned* st) {
    XcdBarrier b; b.bar = bar; b.x = xb_xcc_id(); b.st = st;
    if (threadIdx.x == 0) st[3] = xb_add(&bar[XB_XCNT(b.x)], 1u);
    return b;
}
__device__ __forceinline__ void xcd_barrier_complete(unsigned* bar, unsigned x, unsigned& nloc, unsigned& nx, unsigned& even) {
    const unsigned G = gridDim.x * gridDim.y * gridDim.z;
    unsigned sum, cnt, mine, c32, sp = 0u;
    for (;;) {
        sum = 0u; cnt = 0u; mine = 0u; c32 = 0u;
#pragma unroll
        for (unsigned j = 0; j < 16; ++j) { const unsigned c = xb_ld(&bar[XB_XCNT(j)]); sum += c; cnt += (c > 0u) ? 1u : 0u; mine = (j == x) ? c : mine; c32 += (j < 8u && c == 32u) ? 1u : 0u; }
        if (sum == G) break;
        __builtin_amdgcn_s_sleep(1);
        if ((++sp & 255u) == 0u) { if (xb_ld(&bar[XB_TMO])) break; if (sp > XB_SPIN_CAP) { atomicAdd(&bar[XB_TMO], 1u); break; } }
    }
    nloc = mine > 0u ? mine : 1u; nx = cnt > 0u ? cnt : 1u; even = (c32 == 8u && sum == 256u) ? 1u : 0u;
}
__device__ __forceinline__ void xcd_barrier(unsigned char* wsb, unsigned char* smem, bool local = false) {
    asm volatile("s_waitcnt vmcnt(0)" ::: "memory");
    __syncthreads();
    if (tid_opaque() == 0) {
        unsigned* bar = (unsigned*)opq(wsb + WS_CTL);
        volatile LAS unsigned* st = (volatile LAS unsigned*)(smem + g8::STAGE_BYTES);
        unsigned bx = xb_xcc_id(); asm volatile("" : "+s"(bx));
        __builtin_amdgcn_s_waitcnt(0);
        unsigned nloc = st[0], nx = st[1];
        if (nloc == 0u) { unsigned even; xcd_barrier_complete(bar, bx, nloc, nx, even); st[0] = nloc; st[1] = nx; st[2] = even; }
        const unsigned old = xb_add(&bar[XB_XSUB(bx)], 1u);
        const unsigned gen = old / nloc;
        if (old + 1u == (gen + 1u) * nloc) {
            if (!local) {
                __builtin_amdgcn_fence(__ATOMIC_RELEASE, "agent");
                asm volatile("s_waitcnt vmcnt(0)" ::: "memory");
                const unsigned og = xb_add(&bar[XB_TOP], 1u);
                const unsigned tg = og / nx;
                if (og + 1u == (tg + 1u) * nx) xb_add(&bar[XB_TOPGEN], 1u);
                else XB_SPIN(xb_ld(&bar[XB_TOPGEN]) == tg, bar);
            }
            __builtin_amdgcn_fence(__ATOMIC_ACQUIRE, "agent");
            xb_add(&bar[XB_XGEN(bx)], 1u);
            asm volatile("s_waitcnt vmcnt(0)" ::: "memory");
        } else {
            XB_SPIN(xb_ld(&bar[XB_XGEN(bx)]) == gen, bar);
            __builtin_amdgcn_fence(__ATOMIC_ACQUIRE, "agent");
            asm volatile("s_waitcnt vmcnt(0)" ::: "memory");
        }
    }
    __syncthreads();
}

constexpr int LDS_BYTES = 147456;
constexpr int LDS_MISC = 64 + 1024 + 10240;

__global__ void __launch_bounds__(512, 2) mega_fwd(Params p) {
    extern __shared__ __attribute__((aligned(16))) unsigned char smem[];
    if ((threadIdx.x & 63) == 0) *(volatile LAS unsigned*)(LDS_WTAB + (threadIdx.x >> 6) * 4u) = hw_slot_id();
    if (threadIdx.x == 0) *(u32x4*)(smem + g8::STAGE_BYTES) = (u32x4){0u, 0u, 0u, 0u};
    __syncthreads();
    (void)xcd_barrier_post((unsigned*)(p.ws + WS_CTL), (volatile LAS unsigned*)(smem + g8::STAGE_BYTES));
    int bid = blockIdx.x; const int nblk = gridDim.x; bool xl = false;
#define GRID_BAR() xcd_barrier(p.ws, smem)
#define SEAM_BAR() xcd_barrier(p.ws, smem, xl)
#define RING ((LAS unsigned char*)smem)
#define WSB(off) ((bf16_t*)(ws + (off)))
    phase_prep(p, smem, bid, nblk);
    GRID_BAR();
    { volatile LAS unsigned* st = (volatile LAS unsigned*)(smem + g8::STAGE_BYTES);
      const unsigned even = (unsigned)__builtin_amdgcn_readfirstlane((int)st[2]), rk = (unsigned)__builtin_amdgcn_readfirstlane((int)st[3]);
      xl = (even != 0u) && (nblk == 256);
      if (xl) bid = (int)(rk * 8u + xb_xcc_id()); }
#pragma unroll 1
    for (int layer = 0; layer < 4; ++layer) {
        const int kind = layer % 3, slot = layer / 3;
        const bool cfirst = xl && (bid & 1);
#define CONV_LAYER() do { const int tb = (layer % 3 == 0) ? 2048 : 0; int done = ((const int*)(p.ws + WS_CTL))[CW_QHEAD + layer]; done = __builtin_amdgcn_readfirstlane(done); done = done < CQ_PER_LAYER - tb ? done : CQ_PER_LAYER - tb; \
          conv_range(p, smem, layer * CQ_PER_LAYER + tb + done, (layer + 1) * CQ_PER_LAYER, bid, nblk); } while (0)
#pragma unroll 1
        for (int cstep = 0; cstep < 2; ++cstep) {
        if (cstep == (cfirst ? 0 : 1)) CONV_LAYER();
        if (cstep == 0) {
        if (kind == 0) {
            { unsigned char* ws = opq(p.ws);
              g8::DenseSched S; S.init(T_TOK, 2048, nblk, bid, DM, (const unsigned char*)(ws + WT_LRU_IN) + (size_t)slot * 2048 * 1024, DM, 0);
              g8::gemm_phase<g8::DenseSched, g8::EpiB<1>, 1>(RING, (const char*)(ws + WS_U), DM, DM / 128, S, g8::EpiB<1>{WSB(WS_B0), WSB(WS_B1), nullptr, nullptr, 0.f, DM, 0}, 0x7A7A7A7A); }
            SEAM_BAR();
            phase_lru_mid(p, slot, smem, bid, nblk);
            SEAM_BAR();
            { unsigned char* ws = opq(p.ws); const float* hin = (layer == 0) ? p.in[I_X] : nullptr;
              g8::DenseSched S; S.init(T_TOK, 1024, nblk, bid, DM * 2, WSB(WT_LRU_OUT) + (size_t)slot * 1024 * 1024, DM * 2, 0);
              g8::gemm_phase(RING, (const char*)WSB(WS_B3), DM * 2, DM / 64, S, g8::EpiRes{hin, WSB(WS_H), WSB(WS_H)}); }
            SEAM_BAR();
        } else if (kind == 1) {
            { unsigned char* ws = opq(p.ws);
              g8::DenseSched S; S.init(T_TOK, 1024, nblk, bid, DM, (const unsigned char*)(ws + WT_POOL_IN), DM, 0);
              g8::gemm_phase<g8::DenseSched, g8::EpiB<0>, 1>(RING, (const char*)(ws + WS_U), DM, DM / 128, S, g8::EpiB<0>{WSB(WS_B0), nullptr, nullptr, nullptr, 0.f, DM, 0}, 0x7A7A7A7A); }
            SEAM_BAR();
            { unsigned char* ws = opq(p.ws);
              for (int uu = bid; uu < 256; uu += nblk) { const int L = (uu & 7) * 32 + (uu >> 3); pool_tile(p, L >> 2, L & 3); }
              g8::PoolGrpSched S; S.G = nblk; S.c = bid; S.Wg = (const char*)(ws + WT_POOL_G);
              g8::gemm_phase(RING, (const char*)WSB(WS_B1), 256 * 2, 256 / 64, S, g8::EpiB<3>{WSB(WS_B2), nullptr, nullptr, p.in[I_POOL_SC], 0.f, DM, 0}); }
            SEAM_BAR();
            { unsigned char* ws = opq(p.ws); const float* hin = nullptr;
              g8::DenseSched S; S.init(T_TOK, 1024, nblk, bid, DM * 2, WSB(WT_POOL_OUT), DM * 2, 0);
              g8::gemm_phase(RING, (const char*)WSB(WS_B2), DM * 2, DM / 64, S, g8::EpiRes{hin, WSB(WS_H), WSB(WS_H)}); }
            SEAM_BAR();
        } else {
            { unsigned char* ws = opq(p.ws);
              g8::DenseSched S; S.init(T_TOK, 3072, nblk, bid, DM, (const unsigned char*)(ws + WT_QKV), DM, 0);
              g8::gemm_phase<g8::DenseSched, g8::EpiB<2>, 1>(RING, (const char*)(ws + WS_U), DM, DM / 128, S, g8::EpiB<2>{WSB(WS_B0), WSB(WS_B1), WSB(WS_B2), nullptr, 0.125f * 1.4426950408889634f, DM, 0}, 0x7A7A7A7A); }
            SEAM_BAR();
            phase_sb_attn_fast(p, bid, nblk);
            SEAM_BAR();
            { unsigned char* ws = opq(p.ws); const float* hin = nullptr;
              g8::DenseSched S; S.init(T_TOK, 1024, nblk, bid, DM * 2, WSB(WT_SB_OUT), DM * 2, 0);
              g8::gemm_phase(RING, (const char*)WSB(WS_B3), DM * 2, DM / 64, S, g8::EpiRes{hin, WSB(WS_H), WSB(WS_H)}); }
            SEAM_BAR();
        }
        phase_moe_route_fast(p, layer, smem, bid, nblk);
        } }
        GRID_BAR();
        phase_moe_gemm_fast<1>(p, layer, smem, bid, nblk, xl);
        SEAM_BAR();
        phase_moe_gemm_fast<0>(p, layer, smem, bid, nblk, xl);
        GRID_BAR();
        phase_moe_comb_fast(p, layer, smem, bid, nblk);
        if (layer < 3) SEAM_BAR();
    }
#undef GRID_BAR
#undef SEAM_BAR
#undef CONV_LAYER
}

extern "C" void kernel_launch(void* const* d_in, const int* in_sizes, int n_in, void* d_out, int out_size, void* d_ws, size_t ws_size, hipStream_t stream) {
    Params p{};
    for (int i = 0; i < 25; ++i) p.in[i] = (const float*)d_in[i];
    p.out = (float*)d_out; p.ws = (unsigned char*)d_ws;
    static int grid = 0;
    if (!grid) {
        int dev = 0, cus = 0, per_cu = 0;
        (void)hipGetDevice(&dev);
        (void)hipDeviceGetAttribute(&cus, hipDeviceAttributeMultiprocessorCount, dev);
        (void)hipFuncSetAttribute((const void*)mega_fwd, hipFuncAttributeMaxDynamicSharedMemorySize, LDS_BYTES);
        (void)hipOccupancyMaxActiveBlocksPerMultiprocessor(&per_cu, (const void*)mega_fwd, 512, LDS_BYTES);
        grid = cus * (per_cu < 1 ? per_cu : 1);
        if (grid <= 0) grid = 1;
    }
    (void)hipMemsetAsync(d_ws, 0, 1 * MB, stream);
    hipLaunchKernelGGL(mega_fwd, dim3(grid), dim3(512), LDS_BYTES, stream, p);
}
```

```cpp
#include <hip/hip_runtime.h>
#include <stdint.h>

typedef unsigned short bf16_t;
typedef short bf16x8 __attribute__((ext_vector_type(8)));
typedef float f32x16 __attribute__((ext_vector_type(16)));
typedef float f32x4 __attribute__((ext_vector_type(4)));
typedef float f32x2_t __attribute__((ext_vector_type(2)));
typedef __bf16 bf16x2_t __attribute__((ext_vector_type(2)));
typedef unsigned u32x4 __attribute__((ext_vector_type(4)));
typedef unsigned u32x2 __attribute__((ext_vector_type(2)));

constexpr int T_TOK = 16384, DM = 1024, SEQ = 2048, NB = 8, NE = 32, TOPK = 4, NH = 16, HD = 64;
constexpr float SWI_C = 2.4554669595930157f;
constexpr int ECAP = 16384;
constexpr int PADROWS = 65536 + 32 * 256;
constexpr float RMS_EPS = 1e-6f;

constexpr size_t MB = 1024ull * 1024ull;
constexpr size_t WS_CTL = 0;
constexpr size_t WS_LIST = 1 * MB;
constexpr size_t WS_TOKSLOT = 3 * MB;
constexpr size_t WS_GATES = 4 * MB;
constexpr size_t WS_H = 8 * MB;
constexpr size_t WS_U = WS_H + 64 * MB;
constexpr size_t WS_B0 = WS_U + 32 * MB;
constexpr size_t WS_U8 = WS_U + 16 * MB;
constexpr size_t WS_B1 = WS_B0 + 32 * MB;
constexpr size_t WS_B2 = WS_B1 + 32 * MB;
constexpr size_t WS_B3 = WS_B2 + 32 * MB;
constexpr size_t WS_ACT = WS_B3 + 32 * MB;
constexpr size_t WS_YS = WS_ACT + 160 * MB;
constexpr size_t WS_W = WS_YS + 160 * MB;
constexpr size_t WT_LRU_IN = WS_W;
constexpr size_t WT_LRU_OUT = WT_LRU_IN + 8 * MB;
constexpr size_t WT_POOL_IN = WT_LRU_OUT + 4 * MB;
constexpr size_t WT_POOL_G = WT_POOL_IN + 2 * MB;
constexpr size_t WT_POOL_OUT = WT_POOL_G + 1 * MB;
constexpr size_t WT_QKV = WT_POOL_OUT + 2 * MB;
constexpr size_t WT_SB_OUT = WT_QKV + 6 * MB;
constexpr size_t WT_LRU_A = WT_SB_OUT + 2 * MB;
constexpr size_t WT_LRU_X = WT_LRU_A + 1 * MB;
constexpr size_t WT_ROUTER = WT_LRU_X + 1 * MB;
constexpr size_t WT_GU = WT_ROUTER + 1 * MB;
constexpr size_t WT_DN = WT_GU + 512 * MB;
constexpr size_t WS_END = WT_DN + 256 * MB;
constexpr int CW_CNT = 8192;

struct Params {
    const float* in[25];
    float* out;
    unsigned char* ws;
};
enum { I_X = 0, I_MIXN, I_FFNN, I_FINN, I_LRU_WIN, I_LRU_CW, I_LRU_CB, I_LRU_WA, I_LRU_BA, I_LRU_WX, I_LRU_BX, I_LRU_AP, I_LRU_WOUT,
       I_POOL_WIN, I_POOL_WG, I_POOL_SC, I_POOL_WOUT, I_SB_WQKV, I_SB_WOUT, I_MOE_WR, I_MOE_BR, I_MOE_WGU, I_MOE_BGU, I_MOE_WDN, I_MOE_BDN };

constexpr unsigned LDS_WTAB = 147456u - 64u;
__device__ __forceinline__ unsigned hw_slot_id() { return (unsigned)__builtin_amdgcn_s_getreg(((16 - 1) << 11) | 4); }
__device__ __forceinline__ int tid_opaque() {
    const unsigned hw = hw_slot_id();
    unsigned m = ~0u; asm volatile("" : "+s"(m));
    const int lane = (int)__builtin_amdgcn_mbcnt_hi(m, __builtin_amdgcn_mbcnt_lo(m, 0u));
    const unsigned ent = *(const volatile __attribute__((address_space(3))) unsigned*)(LDS_WTAB + (unsigned)(lane & 7) * 4u);
    const int wi = __builtin_ctzll(__builtin_amdgcn_ballot_w64(ent == hw));
    int t = wi * 64 + lane; asm volatile("" : "+v"(t)); return t;
}
__device__ __forceinline__ float bf2f(bf16_t b) { return __uint_as_float(((unsigned)b) << 16); }
__device__ __forceinline__ unsigned pk2(float lo, float hi) { f32x2_t v = {lo, hi}; bf16x2_t b = __builtin_convertvector(v, bf16x2_t); return __builtin_bit_cast(unsigned, b); }
__device__ __forceinline__ bf16_t f2bf(float f) { return (bf16_t)(pk2(f, 0.f) & 0xffffu); }
__device__ __forceinline__ int crow(int r, int hi) { return (r & 3) + 8 * (r >> 2) + 4 * hi; }
__device__ __forceinline__ float shx(float v, int o, int lane) { return __int_as_float(__builtin_amdgcn_ds_bpermute((lane ^ o) << 2, __float_as_int(v))); }
__device__ __forceinline__ float wave_sum(float v, int lane) {
#pragma unroll
    for (int o = 32; o >= 1; o >>= 1) v += shx(v, o, lane);
    return v;
}
__device__ __forceinline__ void convT_small(const float* src, bf16_t* dst, int nbat, int K, int N, int bid, int nblk) {
    const int tidx = tid_opaque();
    const size_t total = (size_t)nbat * K * N;
    for (size_t i = (size_t)bid * blockDim.x + tidx; i < total; i += (size_t)nblk * blockDim.x) {
        const size_t m = i / ((size_t)K * N), r = i % ((size_t)K * N);
        const int n = (int)(r / K), k = (int)(r % K);
        dst[i] = f2bf(src[m * K * N + (size_t)k * N + n]);
    }
}

__device__ __forceinline__ void norm_row_wave(const float* __restrict__ xrow, const float* __restrict__ g, bf16_t* __restrict__ orow, int lane) {
    f32x4 v[4]; float ss = 0.f;
#pragma unroll
    for (int j = 0; j < 4; ++j) { v[j] = *(const f32x4*)(xrow + j * 256 + lane * 4); ss += v[j][0] * v[j][0] + v[j][1] * v[j][1] + v[j][2] * v[j][2] + v[j][3] * v[j][3]; }
    ss = wave_sum(ss, lane);
    const float rstd = rsqrtf(ss * (1.0f / 1024.0f) + RMS_EPS);
#pragma unroll
    for (int j = 0; j < 4; ++j) {
        const f32x4 gg = *(const f32x4*)(g + j * 256 + lane * 4);
        u32x2 w; w.x = pk2(v[j][0] * rstd * gg[0], v[j][1] * rstd * gg[1]); w.y = pk2(v[j][2] * rstd * gg[2], v[j][3] * rstd * gg[3]);
        *(u32x2*)(orow + j * 256 + lane * 4) = w;
    }
}

__device__ __forceinline__ float clamp448_early(float x) { return __builtin_fminf(__builtin_fmaxf(x, -448.0f), 448.0f); }
__device__ __forceinline__ u32x2 pack8_fp8_early(const f32x4& a, const f32x4& b) {
    int w0 = 0, w1 = 0;
    w0 = __builtin_amdgcn_cvt_pk_fp8_f32(clamp448_early(a[0]), clamp448_early(a[1]), w0, false); w0 = __builtin_amdgcn_cvt_pk_fp8_f32(clamp448_early(a[2]), clamp448_early(a[3]), w0, true);
    w1 = __builtin_amdgcn_cvt_pk_fp8_f32(clamp448_early(b[0]), clamp448_early(b[1]), w1, false); w1 = __builtin_amdgcn_cvt_pk_fp8_f32(clamp448_early(b[2]), clamp448_early(b[3]), w1, true);
    u32x2 r; r.x = (unsigned)w0; r.y = (unsigned)w1; return r;
}
struct PrepJob { const float* src; bf16_t* dst; int K, N; int k0, n0; int f8; };
__device__ __forceinline__ bool prep_decode(const Params& p, int u, PrepJob& J) {
    unsigned char* ws = p.ws;
    const int idx[7] = {I_LRU_WIN, I_LRU_WOUT, I_POOL_WIN, I_POOL_WG, I_POOL_WOUT, I_SB_WQKV, I_SB_WOUT};
    const size_t off[7] = {WT_LRU_IN, WT_LRU_OUT, WT_POOL_IN, WT_POOL_G, WT_POOL_OUT, WT_QKV, WT_SB_OUT};
    const int nbat[7] = {2, 2, 1, 4, 1, 1, 1};
    const int Ks[7] = {1024, 1024, 1024, 256, 1024, 1024, 1024};
    const int Ns[7] = {2048, 1024, 1024, 256, 1024, 3072, 1024};
    const int F8[7] = {1, 0, 1, 0, 0, 1, 0};
    int rem = u;
#pragma unroll
    for (int j = 0; j < 7; ++j) {
        const int ntl = Ns[j] / 256, per = (Ks[j] / 64) * ntl, tot = nbat[j] * per;
        if (rem < tot) {
            const int m = rem / per, r = rem % per;
            J.src = p.in[idx[j]] + (size_t)m * Ks[j] * Ns[j]; J.f8 = F8[j];
            J.dst = F8[j] ? (bf16_t*)(ws + off[j] + (size_t)m * Ks[j] * Ns[j]) : (bf16_t*)(ws + off[j]) + (size_t)m * Ks[j] * Ns[j];
            J.K = Ks[j]; J.N = Ns[j]; J.k0 = (r / ntl) * 64; J.n0 = (r % ntl) * 256; return true;
        }
        rem -= tot;
    }
    return false;
}
__device__ __forceinline__ void phase_prep(const Params& p, unsigned char* lds, int bid, int nblk) {
    const int tidx = tid_opaque();
    unsigned char* ws = p.ws;
    const int lane = tidx & 63, kg = tidx >> 6;
    {
        PrepJob J, Jn; f32x4 v[8], vn[8];
        bool have = prep_decode(p, bid, J);
        if (have) {
#pragma unroll
            for (int j = 0; j < 8; ++j) v[j] = *(const f32x4*)(J.src + (size_t)(J.k0 + kg * 8 + j) * J.N + J.n0 + lane * 4);
        }
#pragma unroll 1
        for (int u = bid; have; u += nblk) {
            const bool hn = prep_decode(p, u + nblk, Jn);
            if (hn) {
#pragma unroll
                for (int j = 0; j < 8; ++j) vn[j] = *(const f32x4*)(Jn.src + (size_t)(Jn.k0 + kg * 8 + j) * Jn.N + Jn.n0 + lane * 4);
            }
            if (J.f8) {
#pragma unroll
                for (int i = 0; i < 4; ++i) {
                    f32x4 a, b; a[0] = v[0][i] * 32.0f; a[1] = v[1][i] * 32.0f; a[2] = v[2][i] * 32.0f; a[3] = v[3][i] * 32.0f; b[0] = v[4][i] * 32.0f; b[1] = v[5][i] * 32.0f; b[2] = v[6][i] * 32.0f; b[3] = v[7][i] * 32.0f;
                    *(u32x2*)(lds + (lane * 4 + i) * 72 + kg * 8) = pack8_fp8_early(a, b);
                }
                __syncthreads();
#pragma unroll
                for (int q = 0; q < 2; ++q) {
                    const int n = q * 128 + (tidx >> 2), ch = tidx & 3;
                    u32x4 w; const u32x2 w0 = *(const u32x2*)(lds + n * 72 + ch * 16), w1 = *(const u32x2*)(lds + n * 72 + ch * 16 + 8); w.x = w0.x; w.y = w0.y; w.z = w1.x; w.w = w1.y;
                    *(u32x4*)((unsigned char*)J.dst + (size_t)(J.n0 + n) * J.K + J.k0 + ch * 16) = w;
                }
            } else {
#pragma unroll
            for (int i = 0; i < 4; ++i) {
                u32x4 w;
                w.x = pk2(v[0][i], v[1][i]); w.y = pk2(v[2][i], v[3][i]); w.z = pk2(v[4][i], v[5][i]); w.w = pk2(v[6][i], v[7][i]);
                *(u32x4*)(lds + (lane * 4 + i) * 144 + kg * 16) = w;
            }
            __syncthreads();
#pragma unroll
            for (int q = 0; q < 4; ++q) {
                const int n = q * 64 + (tidx >> 3), ch = tidx & 7;
                const u32x4 w = *(const u32x4*)(lds + n * 144 + ch * 16);
                *(u32x4*)(J.dst + (size_t)(J.n0 + n) * J.K + J.k0 + ch * 8) = w;
            }
            }
            __syncthreads();
            have = hn; J = Jn;
#pragma unroll
            for (int j = 0; j < 8; ++j) v[j] = vn[j];
        }
    }
    convT_small(p.in[I_LRU_WA], (bf16_t*)(ws + WT_LRU_A), 16, 128, 128, bid, nblk);
    convT_small(p.in[I_LRU_WX], (bf16_t*)(ws + WT_LRU_X), 16, 128, 128, bid, nblk);
    convT_small(p.in[I_MOE_WR], (bf16_t*)(ws + WT_ROUTER), 4, 1024, 32, bid, nblk);
    const int wid = tidx >> 6, nw = blockDim.x >> 6;
    f32x4 gg[4];
#pragma unroll
    for (int j = 0; j < 4; ++j) gg[j] = *(const f32x4*)(p.in[I_MIXN] + j * 256 + lane * 4);
#pragma unroll 1
    for (int t0 = (bid * nw + wid) * 4; t0 < T_TOK; t0 += nblk * nw * 4) {
        f32x4 v[4][4];
#pragma unroll
        for (int a = 0; a < 4; ++a)
#pragma unroll
            for (int j = 0; j < 4; ++j) v[a][j] = *(const f32x4*)(p.in[I_X] + (size_t)(t0 + a) * DM + j * 256 + lane * 4);
#pragma unroll
        for (int a = 0; a < 4; ++a) {
            float ss = 0.f;
#pragma unroll
            for (int j = 0; j < 4; ++j) ss += v[a][j][0] * v[a][j][0] + v[a][j][1] * v[a][j][1] + v[a][j][2] * v[a][j][2] + v[a][j][3] * v[a][j][3];
            ss = wave_sum(ss, lane);
            const float rstd = rsqrtf(ss * (1.0f / 1024.0f) + RMS_EPS);
            unsigned char* orow = ws + WS_U + (size_t)(t0 + a) * DM;
#pragma unroll
            for (int j = 0; j < 4; ++j) {
                int w8 = 0;
                w8 = __builtin_amdgcn_cvt_pk_fp8_f32(clamp448_early(v[a][j][0] * rstd * gg[j][0]), clamp448_early(v[a][j][1] * rstd * gg[j][1]), w8, false);
                w8 = __builtin_amdgcn_cvt_pk_fp8_f32(clamp448_early(v[a][j][2] * rstd * gg[j][2]), clamp448_early(v[a][j][3] * rstd * gg[j][3]), w8, true);
                *(int*)(orow + j * 256 + lane * 4) = w8;
            }
        }
    }
}

#define LAS __attribute__((address_space(3)))
namespace g8 {
constexpr int HTB = 128 * 64 * 2;
constexpr int STAGE_BYTES = 8 * HTB;
__device__ __forceinline__ int lds_byte(int r, int c) { const int st = (r >> 4) * 2 + (c >> 5), rr = r & 15, cc = c & 31, ob = rr * 64 + cc * 2; return st * 1024 + (ob ^ (((ob >> 9) & 1) << 5)); }
__device__ __forceinline__ void stage_rc(int b, int& R, int& C) { const int st = b / 1024, sb = b % 1024, swz = sb ^ (((sb >> 9) & 1) << 5); R = (st >> 1) * 16 + swz / 64; C = (st & 1) * 32 + (swz % 64) / 2; }
__device__ __forceinline__ int perm32(int rho) { const int n = rho >> 4, i = rho & 15; return 8 * (i >> 2) + 4 * n + (i & 3); }

struct Unit { const char* Bb; int a0; int orow; int ocol; int e; };

typedef f32x4 Acc[2][2][4][2];

typedef int v8i __attribute__((ext_vector_type(8)));
typedef int v4i __attribute__((ext_vector_type(4)));
template <class Sched, class Epi, int FP8 = 0>
__device__ __forceinline__ void gemm_phase(LAS unsigned char* lds, const char* Abase, int ldb_bytes, int nt, const Sched& S, const Epi& E, int wscale = 0x7F7F7F7F) {
    const int tid = tid_opaque(), wid = __builtin_amdgcn_readfirstlane(tid >> 6), lane = tid & 63, wr = wid >> 2, wc = wid & 3, fr = lane & 15, fq = lane >> 4;
    int R[2], C[2]; unsigned voffB[2];
#pragma unroll
    for (int i = 0; i < 2; ++i) { stage_rc(tid * 16 + i * 8192, R[i], C[i]); const int Rb = (R[i] & ~31) + perm32(R[i] & 31); voffB[i] = (unsigned)(Rb * ldb_bytes + C[i] * 2); }
    const unsigned ldsw = (unsigned)wid * 1024u;
    const int aoffl = lds_byte(wr * 64 + fr, fq * 8), boffl = lds_byte(wc * 32 + fr, fq * 8);
#define G8_SA(b, h) (((b) * 2 + (h)) * g8::HTB)
#define G8_SB(b, h) ((4 + (b) * 2 + (h)) * g8::HTB)
#define G8_STG_A(bufoff, kptr, h) do { _Pragma("unroll") for (int _i = 0; _i < 2; ++_i) \
        __builtin_amdgcn_global_load_lds((const unsigned*)((const char*)(kptr) + aoff[h][_i]), (LAS unsigned*)(lds + (bufoff) + ldsw + _i * 8192), 16, 0, 0); } while (0)
#define G8_STG_B(bufoff, bptr) do { _Pragma("unroll") for (int _i = 0; _i < 2; ++_i) \
        __builtin_amdgcn_global_load_lds((const unsigned*)((const char*)(bptr) + voffB[_i]), (LAS unsigned*)(lds + (bufoff) + ldsw + _i * 8192), 16, 0, 0); } while (0)
#define G8_LDA(dst, b, h) do { _Pragma("unroll") for (int m = 0; m < 4; ++m) _Pragma("unroll") for (int k = 0; k < 2; ++k) dst[m][k] = *(const LAS bf16x8*)(lds + G8_SA(b, h) + aoffl + m * 2048 + k * 1024); } while (0)
#define G8_LDB(dst, b, h) do { _Pragma("unroll") for (int n = 0; n < 2; ++n) _Pragma("unroll") for (int k = 0; k < 2; ++k) dst[n][k] = *(const LAS bf16x8*)(lds + G8_SB(b, h) + boffl + n * 2048 + k * 1024); } while (0)
#define G8_CAT(x) __builtin_shufflevector(__builtin_bit_cast(g8::v4i, x[0]), __builtin_bit_cast(g8::v4i, x[1]), 0, 1, 2, 3, 4, 5, 6, 7)
#define G8_MMA(ai, bj, At, Bt) do { __builtin_amdgcn_s_setprio(1); _Pragma("unroll") for (int m = 0; m < 4; ++m) _Pragma("unroll") for (int n = 0; n < 2; ++n) { \
        if (FP8) acc[ai][bj][m][n] = __builtin_amdgcn_mfma_scale_f32_16x16x128_f8f6f4(G8_CAT(Bt[n]), G8_CAT(At[m]), acc[ai][bj][m][n], 0, 0, 0, wscale, 0, 0x7F7F7F7F); \
        else { _Pragma("unroll") for (int k = 0; k < 2; ++k) acc[ai][bj][m][n] = __builtin_amdgcn_mfma_f32_16x16x32_bf16(Bt[n][k], At[m][k], acc[ai][bj][m][n], 0, 0, 0); } } \
        __builtin_amdgcn_s_setprio(0); } while (0)
#define G8_WAIT_V(n) asm volatile("s_waitcnt vmcnt(" #n ")" ::: "memory")
#define G8_WAIT_L(n) asm volatile("s_waitcnt lgkmcnt(" #n ")" ::: "memory")
#define G8_BAR __builtin_amdgcn_s_barrier()
#define G8_SCHED __builtin_amdgcn_sched_barrier(0)
    Unit cur, nxt; int ui = 0;
    if (!S.next(0, cur)) return;
    Acc acc;
    f32x4 ib[4];
    if constexpr (Epi::HAS_INIT) E.load_init(cur, wc, fq, ib);
#pragma unroll
    for (int a = 0; a < 2; ++a)
#pragma unroll
        for (int b = 0; b < 2; ++b)
#pragma unroll
            for (int m = 0; m < 4; ++m)
#pragma unroll
                for (int n = 0; n < 2; ++n) { if constexpr (Epi::HAS_INIT) acc[a][b][m][n] = ib[2 * b + n]; else acc[a][b][m][n] = (f32x4){0.f, 0.f, 0.f, 0.f}; }
    if constexpr (Epi::HAS_TILE_INIT) E.init_tile(acc, cur, wr, wc, fr, fq);
    bf16x8 At[4][2], B0[2][2], B1[2][2];
    unsigned aoff[2][2];
    S.aoffs(cur, R, C, aoff);
    const char* cB = cur.Bb; const int chB = S.hB();
#define G8_KOFF(u, s) ((size_t)(((s) & (nt - 1)) * 128))
    { const size_t k0 = G8_KOFF(cur, 0), k1 = G8_KOFF(cur, 1);
    G8_STG_B(G8_SB(0, 0), cB + k0); G8_STG_B(G8_SB(0, 1), cB + chB + k0); G8_STG_A(G8_SA(0, 0), Abase + k0, 0); G8_STG_A(G8_SA(0, 1), Abase + k0, 1);
    if (wr == 1) G8_BAR;
    G8_WAIT_V(2); G8_BAR;
    G8_STG_B(G8_SB(1, 0), cB + k1); G8_STG_A(G8_SA(1, 0), Abase + k1, 0); G8_STG_B(G8_SB(1, 1), cB + chB + k1);
    G8_WAIT_V(6); G8_BAR; }
    for (;;) {
        const bool has_next = S.next(ui + 1, nxt);
        const char* nB = has_next ? nxt.Bb : cB;
#pragma unroll 1
        for (int t = 0; t < nt; t += 2) {
            const bool last = (t == nt - 2);
            const Unit& nu = has_next ? nxt : cur;
            const size_t o1 = G8_KOFF(cur, t + 1), o2 = last ? G8_KOFF(nu, 0) : G8_KOFF(cur, t + 2), o3 = last ? G8_KOFF(nu, 1) : G8_KOFF(cur, t + 3);
            const char* a1 = Abase + o1;
            const char* a2 = Abase + o2; const char* b2 = (last ? nB : cB) + o2; const int hb2 = chB;
            const char* a3 = Abase + o3; const char* b3 = (last ? nB : cB) + o3;
            G8_LDB(B0, 0, 0); G8_LDB(B1, 0, 1); G8_SCHED; G8_LDA(At, 0, 0); G8_STG_A(G8_SA(1, 1), a1, 1);
            if (last && has_next) S.aoffs(nxt, R, C, aoff);
            G8_WAIT_V(8); G8_WAIT_L(0); G8_BAR; G8_MMA(0, 0, At, B0); G8_MMA(0, 1, At, B1); G8_BAR; G8_SCHED;
            G8_LDA(At, 0, 1); G8_STG_B(G8_SB(0, 0), b2); G8_STG_B(G8_SB(0, 1), b2 + hb2); G8_STG_A(G8_SA(0, 0), a2, 0);
            G8_WAIT_V(8); G8_WAIT_L(0); G8_BAR; G8_MMA(1, 0, At, B0); G8_MMA(1, 1, At, B1); G8_BAR; G8_SCHED;
            G8_LDB(B0, 1, 0); G8_LDB(B1, 1, 1); G8_SCHED; G8_LDA(At, 1, 0); G8_STG_A(G8_SA(0, 1), a2, 1);
            G8_WAIT_V(8); G8_WAIT_L(0); G8_BAR; G8_MMA(0, 0, At, B0); G8_MMA(0, 1, At, B1); G8_BAR; G8_SCHED;
            G8_LDA(At, 1, 1); G8_STG_B(G8_SB(1, 0), b3); G8_STG_B(G8_SB(1, 1), b3 + hb2); G8_STG_A(G8_SA(1, 0), a3, 0);
            G8_WAIT_V(8); G8_WAIT_L(0); G8_BAR; G8_MMA(1, 0, At, B0); G8_MMA(1, 1, At, B1); G8_BAR; G8_SCHED;
        }
        if (wr == 0) G8_BAR;
        if constexpr (Epi::HAS_INIT) { if (has_next) E.load_init(nxt, wc, fq, ib); }
        E(acc, cur, wr, wc, fr, fq);
        if (!has_next) break;
#pragma unroll
        for (int a = 0; a < 2; ++a)
#pragma unroll
            for (int b = 0; b < 2; ++b)
#pragma unroll
                for (int m = 0; m < 4; ++m)
#pragma unroll
                    for (int n = 0; n < 2; ++n) { if constexpr (Epi::HAS_INIT) acc[a][b][m][n] = ib[2 * b + n]; else acc[a][b][m][n] = (f32x4){0.f, 0.f, 0.f, 0.f}; }
        if constexpr (Epi::HAS_TILE_INIT) E.init_tile(acc, nxt, wr, wc, fr, fq);
        cur = nxt; cB = nB; ++ui;
        if (wr == 1) G8_BAR;
    }
    G8_WAIT_V(0);
    G8_BAR;
#undef G8_SA
#undef G8_SB
#undef G8_STG_A
#undef G8_STG_B
#undef G8_LDA
#undef G8_LDB
#undef G8_MMA
#undef G8_KOFF
#undef G8_CAT
#undef G8_WAIT_V
#undef G8_WAIT_L
#undef G8_BAR
#undef G8_SCHED
}

struct DenseSched {
    int nM, nN, nwg, G, c, abytes; const char* Bt; int bbytes; int acolB;
    __device__ __forceinline__ int hB() const { return 128 * bbytes; }
    __device__ __forceinline__ void init(int M, int N, int G_, int c_, int abytes_, const void* Bt_, int bbytes_, int acolB_) { nM = M / 256; nN = N / 256; nwg = nM * nN; G = G_; c = c_; abytes = abytes_; Bt = (const char*)Bt_; bbytes = bbytes_; acolB = acolB_; }
    __device__ __forceinline__ bool next(int i, Unit& u) const {
        const long L = (long)i * G + c; if (L >= nwg) return false;
        int wgid = (int)L; { const int q = nwg / 8, r = nwg % 8, xcd = wgid % 8, off = wgid / 8; wgid = (xcd < r ? xcd * (q + 1) : r * (q + 1) + (xcd - r) * q) + off; }
        const int nig = 8 * nN, gid = wgid / nig, fm = gid * 8, gsz = (nM - fm) < 8 ? (nM - fm) : 8;
        const int pm = fm + ((wgid % nig) % gsz), pn = (wgid % nig) / gsz;
        u.a0 = pm * 256; u.orow = pm * 256; u.ocol = pn * 256; u.e = 0; u.Bb = Bt + (size_t)pn * 256 * bbytes; return true;
    }
    __device__ __forceinline__ void aoffs(const Unit& u, const int (&R)[2], const int (&C)[2], unsigned (&aoff)[2][2]) const {
#pragma unroll
        for (int h = 0; h < 2; ++h)
#pragma unroll
            for (int i = 0; i < 2; ++i) aoff[h][i] = (unsigned)((u.a0 + h * 128 + R[i]) * abytes + acolB + C[i] * 2);
    }
};

__device__ __forceinline__ u32x4 pack8(const f32x4& a, const f32x4& b) { u32x4 w; w.x = pk2(a[0], a[1]); w.y = pk2(a[2], a[3]); w.z = pk2(b[0], b[1]); w.w = pk2(b[2], b[3]); return w; }
__device__ __forceinline__ float fast_rcp(float x) { return __builtin_amdgcn_rcpf(x); }
__device__ __forceinline__ float clamp448(float x) { return __builtin_fminf(__builtin_fmaxf(x, -448.0f), 448.0f); }
__device__ __forceinline__ u32x2 pack8_fp8(const f32x4& a, const f32x4& b) {
    int w0 = 0, w1 = 0;
    w0 = __builtin_amdgcn_cvt_pk_fp8_f32(clamp448(a[0]), clamp448(a[1]), w0, false); w0 = __builtin_amdgcn_cvt_pk_fp8_f32(clamp448(a[2]), clamp448(a[3]), w0, true);
    w1 = __builtin_amdgcn_cvt_pk_fp8_f32(clamp448(b[0]), clamp448(b[1]), w1, false); w1 = __builtin_amdgcn_cvt_pk_fp8_f32(clamp448(b[2]), clamp448(b[3]), w1, true);
    u32x2 r; r.x = (unsigned)w0; r.y = (unsigned)w1; return r;
}
__device__ __forceinline__ float clamp448m(float x) { return __builtin_amdgcn_fmed3f(x, -448.0f, 448.0f); }
__device__ __forceinline__ u32x2 pack8_fp8_m3(const f32x4& a, const f32x4& b) {
    int w0 = 0, w1 = 0;
    w0 = __builtin_amdgcn_cvt_pk_fp8_f32(clamp448m(a[0]), clamp448m(a[1]), w0, false); w0 = __builtin_amdgcn_cvt_pk_fp8_f32(clamp448m(a[2]), clamp448m(a[3]), w0, true);
    w1 = __builtin_amdgcn_cvt_pk_fp8_f32(clamp448m(b[0]), clamp448m(b[1]), w1, false); w1 = __builtin_amdgcn_cvt_pk_fp8_f32(clamp448m(b[2]), clamp448m(b[3]), w1, true);
    u32x2 r; r.x = (unsigned)w0; r.y = (unsigned)w1; return r;
}
__device__ __forceinline__ u32x2 pack8_fp8_noclamp(const f32x4& a, const f32x4& b) {
    int w0 = 0, w1 = 0;
    w0 = __builtin_amdgcn_cvt_pk_fp8_f32(a[0], a[1], w0, false); w0 = __builtin_amdgcn_cvt_pk_fp8_f32(a[2], a[3], w0, true);
    w1 = __builtin_amdgcn_cvt_pk_fp8_f32(b[0], b[1], w1, false); w1 = __builtin_amdgcn_cvt_pk_fp8_f32(b[2], b[3], w1, true);
    u32x2 r; r.x = (unsigned)w0; r.y = (unsigned)w1; return r;
}
__device__ __forceinline__ float gelu_fast(float x) { const float t = x * __builtin_fmaf(x * x, -0.10294324f, -2.3022082f); return x * fast_rcp(1.0f + __builtin_amdgcn_exp2f(t)); }
#define G8_FOR_ROWS for (int ai = 0; ai < 2; ++ai) for (int m = 0; m < 4; ++m)
__device__ __forceinline__ u32x4 rowmajor16(const u32x4& w, int srcb) {
    u32x4 r; r.x = (unsigned)__builtin_amdgcn_ds_bpermute(srcb, (int)w.x); r.y = (unsigned)__builtin_amdgcn_ds_bpermute(srcb, (int)w.y);
    r.z = (unsigned)__builtin_amdgcn_ds_bpermute(srcb, (int)w.z); r.w = (unsigned)__builtin_amdgcn_ds_bpermute(srcb, (int)w.w); return r;
}

template <int MODE> struct EpiB {
    bf16_t* o0; bf16_t* o1; bf16_t* o2; const float* sc; float qs; int ld; int coff;
    static constexpr bool HAS_INIT = (MODE == 4), HAS_TILE_INIT = false;
    __device__ __forceinline__ void load_init(const Unit& u, int wc, int fq, f32x4 (&b)[4]) const {
        const float* bp = sc + u.e * 1024 + u.ocol + coff + wc * 32 + 8 * fq;
#pragma unroll
        for (int bj = 0; bj < 2; ++bj) { b[2 * bj] = *(const f32x4*)(bp + bj * 128) * 16.0f; b[2 * bj + 1] = *(const f32x4*)(bp + bj * 128 + 4) * 16.0f; }
    }
    __device__ __forceinline__ void operator()(const Acc& acc, const Unit& u, int wr, int wc, int fr, int fq) const {
        if constexpr (MODE == 4) {
            int ln = fr + 16 * fq; asm volatile("" : "+v"(ln));
            unsigned char* yb = (unsigned char*)o0; const int c8 = u.ocol + coff + wc * 32 + 8 * (ln >> 4);
#pragma unroll
            G8_FOR_ROWS {
                unsigned char* rp = yb + (size_t)(u.orow + ai * 128 + wr * 64 + m * 16 + (ln & 15)) * ld + c8;
#pragma unroll
                for (int bj = 0; bj < 2; ++bj) *(u32x2*)(rp + bj * 128) = pack8_fp8_m3(acc[ai][bj][m][0], acc[ai][bj][m][1]);
            }
            return;
        }
        bf16_t* base = o0; int col = u.ocol; float mul = 1.0f; bool gel = false;
        if (MODE == 1) { if (col < 1024) gel = true; else { base = o1; col -= 1024; } }
        if (MODE == 2) { if (col < 1024) mul = qs; else if (col < 2048) { base = o1; col -= 1024; } else { base = o2; col -= 2048; } }
        const int ln = fr + 16 * fq, fr2 = ln >> 2, fq2 = ln & 3, srcb = (fr2 + 16 * fq2) << 2;
        const int col2 = col + coff + wc * 32 + 8 * fq2;
        col += coff + wc * 32 + 8 * fq;
        f32x4 s0[2], s1[2];
        if (MODE == 3) {
#pragma unroll
            for (int bj = 0; bj < 2; ++bj) { s0[bj] = *(const f32x4*)(sc + col + bj * 128); s1[bj] = *(const f32x4*)(sc + col + bj * 128 + 4); }
        }
#pragma unroll
        G8_FOR_ROWS {
            bf16_t* rowp = base + (size_t)(u.orow + ai * 128 + wr * 64 + m * 16 + fr2) * ld + col2;
#pragma unroll
            for (int bj = 0; bj < 2; ++bj) {
                f32x4 v0 = acc[ai][bj][m][0], v1 = acc[ai][bj][m][1];
                if (MODE == 1) { if (gel) {
#pragma unroll
                    for (int j = 0; j < 4; ++j) { v0[j] = gelu_fast(v0[j]); v1[j] = gelu_fast(v1[j]); } } }
                if (MODE == 2) { v0 = v0 * mul; v1 = v1 * mul; }
                if (MODE == 3) { v0 = v0 * s0[bj]; v1 = v1 * s1[bj]; }
                *(u32x4*)(rowp + bj * 128) = rowmajor16(pack8(v0, v1), srcb);
            }
        }
    }
};
struct EpiRes {
    const float* hin32; const bf16_t* hin16; bf16_t* hout;
    static constexpr bool HAS_INIT = false, HAS_TILE_INIT = true;
    __device__ __forceinline__ void init_tile(Acc& acc, const Unit& u, int wr, int wc, int fr, int fq) const {
        const int col = u.ocol + wc * 32 + 8 * fq;
#pragma unroll
        G8_FOR_ROWS {
            const size_t ro = (size_t)(u.orow + ai * 128 + wr * 64 + m * 16 + fr) * DM + col;
#pragma unroll
            for (int bj = 0; bj < 2; ++bj) {
                f32x4 h0, h1;
                if (hin32) { h0 = *(const f32x4*)(hin32 + ro + bj * 128); h1 = *(const f32x4*)(hin32 + ro + bj * 128 + 4); }
                else { const u32x4 w = *(const u32x4*)(hin16 + ro + bj * 128);
                    h0[0] = __uint_as_float(w.x << 16); h0[1] = __uint_as_float(w.x & 0xffff0000u); h0[2] = __uint_as_float(w.y << 16); h0[3] = __uint_as_float(w.y & 0xffff0000u);
                    h1[0] = __uint_as_float(w.z << 16); h1[1] = __uint_as_float(w.z & 0xffff0000u); h1[2] = __uint_as_float(w.w << 16); h1[3] = __uint_as_float(w.w & 0xffff0000u); }
                acc[ai][bj][m][0] = h0; acc[ai][bj][m][1] = h1;
            }
        }
    }
    __device__ __forceinline__ void operator()(const Acc& acc, const Unit& u, int wr, int wc, int fr, int fq) const {
        const int ln = fr + 16 * fq, fr2 = ln >> 2, fq2 = ln & 3, srcb = (fr2 + 16 * fq2) << 2;
        const int col = u.ocol + wc * 32 + 8 * fq2;
#pragma unroll
        G8_FOR_ROWS {
            const size_t ro = (size_t)(u.orow + ai * 128 + wr * 64 + m * 16 + fr2) * DM + col;
#pragma unroll
            for (int bj = 0; bj < 2; ++bj) *(u32x4*)(hout + ro + bj * 128) = rowmajor16(pack8(acc[ai][bj][m][0], acc[ai][bj][m][1]), srcb);
        }
    }
};

struct PoolGrpSched {
    int G, c; const char* Wg;
    __device__ __forceinline__ int hB() const { return 128 * 256 * 2; }
    __device__ __forceinline__ bool next(int i, Unit& u) const {
        const int uu = i * G + c; if (uu >= 256) return false;
        const int L = (uu & 7) * 32 + (uu >> 3);
        const int g = L & 3, pm = L >> 2;
        u.a0 = pm * 256; u.orow = pm * 256; u.ocol = g * 256; u.e = g; u.Bb = Wg + (size_t)g * 256 * 256 * 2; return true;
    }
    __device__ __forceinline__ void aoffs(const Unit& u, const int (&R)[2], const int (&C)[2], unsigned (&aoff)[2][2]) const {
#pragma unroll
        for (int h = 0; h < 2; ++h)
#pragma unroll
            for (int i = 0; i < 2; ++i) aoff[h][i] = (unsigned)((u.a0 + h * 128 + R[i]) * DM + u.e * 256 + C[i]) * 2u;
    }
};

constexpr int MOE_TAB_PS = 0, MOE_TAB_CUM = 64, MOE_TAB_UL = 128, MOE_TAB_CNT = 160, MOE_TAB_ROW = 256, MOE_MAXU = 10;
template <int G1> struct MoeSched {
    __device__ __forceinline__ int hB() const { return G1 ? 1024 * 1024 : 128 * 1024; }
    LAS const int* tab; int total, G, c; const char* W; bool xl;
    __device__ __forceinline__ bool search(int i, int& e, int& rt, int& ct) const {
        int wgid;
        if (xl) {
            const int Wd = G1 ? 8 : 4, NR = total / Wd, x = c & 7;
            const int R0 = (x * NR) >> 3, R1 = ((x + 1) * NR) >> 3, off = i * (G >> 3) + (c >> 3);
            if (off >= (R1 - R0) * Wd) return false;
            wgid = R0 * Wd + (G1 ? off : (R1 - R0) * Wd - 1 - off);
        } else {
            const int L = i * G + c; if (L >= total) return false;
            const int q = total / 8, r = total % 8, xcd = L % 8, off = L / 8;
            wgid = (xcd < r ? xcd * (q + 1) : r * (q + 1) + (xcd - r) * q) + off;
        }
        e = 0;
#pragma unroll 1
        for (int j = 1; j < NE; ++j) if (tab[MOE_TAB_CUM + j] <= wgid) e = j;
        const int rem = wgid - tab[MOE_TAB_CUM + e];
        if (G1) { rt = rem >> 3; ct = rem & 7; } else { rt = rem >> 2; ct = rem & 3; }
        return true;
    }
    __device__ __forceinline__ bool decode(int i, int& e, int& rt, int& ct) const {
        if (i >= MOE_MAXU) return false;
        const int v = tab[MOE_TAB_UL + i]; if (v < 0) return false;
        e = v >> 16; rt = (v >> 8) & 255; ct = v & 255; return true;
    }
    __device__ __forceinline__ bool next(int i, Unit& u) const {
        int e, rt, ct; if (!decode(i, e, rt, ct)) return false;
        u.e = e; u.orow = tab[MOE_TAB_PS + e] + rt * 256;
        if (G1) { u.ocol = ct * 128; u.Bb = W + ((size_t)e * 2048 + ct * 128) * 1024; u.a0 = i; }
        else    { u.ocol = ct * 256; u.Bb = W + ((size_t)e * 1024 + ct * 256) * 1024; u.a0 = u.orow; }
        return true;
    }
    __device__ __forceinline__ void aoffs(const Unit& u, const int (&R)[2], const int (&C)[2], unsigned (&aoff)[2][2]) const {
#pragma unroll
        for (int h = 0; h < 2; ++h)
#pragma unroll
            for (int i = 0; i < 2; ++i) {
                const int row = G1 ? tab[MOE_TAB_ROW + u.a0 * 256 + h * 128 + R[i]] : (u.a0 + h * 128 + R[i]);
                aoff[h][i] = (unsigned)(row * DM + C[i] * 2);
            }
    }
};
struct EpiG1 {
    unsigned char* act; const float* bgu;
    static constexpr bool HAS_INIT = true, HAS_TILE_INIT = false;
    __device__ __forceinline__ void load_init(const Unit& u, int wc, int fq, f32x4 (&b)[4]) const {
        const float* bp = bgu + (size_t)u.e * 2048 + u.ocol + wc * 32 + 8 * fq;
        b[0] = *(const f32x4*)bp * SWI_C; b[1] = *(const f32x4*)(bp + 4) * SWI_C; b[2] = *(const f32x4*)(bp + 1024) + 1.0f; b[3] = *(const f32x4*)(bp + 1028) + 1.0f;
    }
    __device__ __forceinline__ void operator()(const Acc& acc, const Unit& u, int wr, int wc, int fr, int fq) const {
        const int col = u.ocol + wc * 32 + 8 * fq;
#pragma unroll
        G8_FOR_ROWS {
            f32x4 o[2];
#pragma unroll
            for (int n = 0; n < 2; ++n) {
                const f32x4 g = acc[ai][0][m][n], up = acc[ai][1][m][n];
#pragma unroll
                for (int jp = 0; jp < 2; ++jp) {
                    f32x2_t gt2, uu2, d2, r2;
#pragma unroll
                    for (int q = 0; q < 2; ++q) {
                        float gt; asm("v_min_f32_e32 %0, %1, %2" : "=v"(gt) : "s"(7.0f * SWI_C), "v"(g[2 * jp + q]));
                        gt2[q] = gt; uu2[q] = __builtin_amdgcn_fmed3f(up[2 * jp + q], -6.0f, 8.0f); d2[q] = __builtin_amdgcn_exp2f(-gt);
                    }
                    d2 = d2 + 1.0f;
                    r2[0] = fast_rcp(d2[0]); r2[1] = fast_rcp(d2[1]);
                    const f32x2_t o2 = (uu2 * gt2) * r2;
                    o[n][2 * jp] = o2[0]; o[n][2 * jp + 1] = o2[1];
                }
            }
            *(u32x2*)(act + (size_t)(u.orow + ai * 128 + wr * 64 + m * 16 + fr) * DM + col) = pack8_fp8_noclamp(o[0], o[1]);
        }
    }
};
}

constexpr int CQ_IDLE_MASK = 3;
constexpr unsigned CQ_TICKS_PER_UNIT = 2400u;
constexpr int CQ_PER_LAYER = 6144, CQ_TOTAL = 4 * CQ_PER_LAYER, CW_QHEAD = 8448;
struct CqJob { const float* src; unsigned char* dst; int N, k0, n0; float sc; };
__device__ __forceinline__ void convq_decode(const Params& p, int q, CqJob& J) {
    const int l = q / CQ_PER_LAYER; int j = q - l * CQ_PER_LAYER;
    if (j < 4096) { const int m = j >> 7, r = j & 127; J.N = 2048; J.k0 = (r >> 3) * 64; J.n0 = (r & 7) * 256;
        J.src = p.in[I_MOE_WGU] + (size_t)(l * NE + m) * 1024 * 2048; J.dst = (p.ws + WT_GU) + (size_t)(l * NE + m) * 2048 * 1024; J.sc = (J.n0 < 1024) ? 32.0f * SWI_C : 32.0f; }
    else { j -= 4096; const int m = j >> 6, r = j & 63; J.N = 1024; J.k0 = (r >> 2) * 64; J.n0 = (r & 3) * 256;
        J.src = p.in[I_MOE_WDN] + (size_t)(l * NE + m) * 1024 * 1024; J.dst = (p.ws + WT_DN) + (size_t)(l * NE + m) * 1024 * 1024; J.sc = 64.0f / SWI_C; }
}
__device__ __forceinline__ void conv_range(const Params& p, unsigned char* smem, int first, int last, int bid, int nblk) {
    const int tidx = tid_opaque(), lane = tidx & 63, kg = tidx >> 6;
    int q = first + bid;
    __syncthreads();
    if (q >= last) return;
    CqJob J, Jn; f32x4 v[8], vn[8];
    convq_decode(p, q, J);
#pragma unroll
    for (int i = 0; i < 8; ++i) v[i] = __builtin_nontemporal_load((const f32x4*)(J.src + (size_t)(J.k0 + kg * 8 + i) * J.N + J.n0 + lane * 4));
#pragma unroll 1
    for (;;) {
        const int qn = q + nblk; const bool hn = qn < last;
        if (hn) {
            convq_decode(p, qn, Jn);
#pragma unroll
            for (int i = 0; i < 8; ++i) vn[i] = __builtin_nontemporal_load((const f32x4*)(Jn.src + (size_t)(Jn.k0 + kg * 8 + i) * Jn.N + Jn.n0 + lane * 4));
        }
#pragma unroll
        for (int i = 0; i < 4; ++i) {
            f32x4 a, b; a[0] = v[0][i] * J.sc; a[1] = v[1][i] * J.sc; a[2] = v[2][i] * J.sc; a[3] = v[3][i] * J.sc; b[0] = v[4][i] * J.sc; b[1] = v[5][i] * J.sc; b[2] = v[6][i] * J.sc; b[3] = v[7][i] * J.sc;
            *(u32x2*)(smem + (lane * 4 + i) * 72 + kg * 8) = g8::pack8_fp8(a, b);
        }
        __syncthreads();
#pragma unroll
        for (int q4 = 0; q4 < 2; ++q4) {
            const int nn = q4 * 128 + (tidx >> 2), ch = tidx & 3;
            u32x4 w; const u32x2 w0 = *(const u32x2*)(smem + nn * 72 + ch * 16), w1 = *(const u32x2*)(smem + nn * 72 + ch * 16 + 8); w.x = w0.x; w.y = w0.y; w.z = w1.x; w.w = w1.y;
            *(u32x4*)(J.dst + (size_t)(J.n0 + nn) * 1024 + J.k0 + ch * 16) = w;
        }
        __syncthreads();
        if (!hn) break;
        q = qn; J = Jn;
#pragma unroll
        for (int i = 0; i < 8; ++i) v[i] = vn[i];
    }
}

constexpr int LDS_MISC_OFF = 64;
template <int G1>
__device__ __forceinline__ void phase_moe_gemm_fast(const Params& p, int layer, unsigned char* smem, int bid, int nblk, bool xl) {
    const int tidx = tid_opaque();
    unsigned char* ws = p.ws;
    LAS int* tab = (LAS int*)(smem + g8::STAGE_BYTES + LDS_MISC_OFF);
    const int* cnt = (const int*)(ws + WS_CTL) + CW_CNT + layer * NE;
    if (tidx < 32) {
        if constexpr (G1 != 0) {
            const int c = cnt[tidx], tiles = (c + 255) >> 8; int incl = tiles;
#pragma unroll
            for (int off = 1; off < 32; off <<= 1) { const int v = __builtin_amdgcn_ds_bpermute((tidx >= off ? tidx - off : tidx) << 2, incl); if (tidx >= off) incl += v; }
            const int excl = incl - tiles;
            tab[g8::MOE_TAB_PS + tidx] = excl << 8; tab[g8::MOE_TAB_CUM + tidx] = excl * 8; tab[g8::MOE_TAB_CNT + tidx] = c;
            if (tidx == 31) { tab[g8::MOE_TAB_PS + NE] = incl << 8; tab[g8::MOE_TAB_CUM + NE] = incl * 8; }
        } else {
            tab[g8::MOE_TAB_CUM + tidx] = (tab[g8::MOE_TAB_PS + tidx] >> 8) * 4;
            if (tidx == 31) tab[g8::MOE_TAB_CUM + NE] = (tab[g8::MOE_TAB_PS + NE] >> 8) * 4;
        }
    }
    __syncthreads();
    g8::MoeSched<G1> S; S.tab = (LAS const int*)tab; S.total = tab[g8::MOE_TAB_CUM + NE]; S.G = nblk; S.c = bid; S.xl = xl;
    S.W = (const char*)(ws + (G1 ? WT_GU : WT_DN)) + (size_t)layer * NE * (G1 ? 2048 : 1024) * 1024;
    if (tidx < g8::MOE_MAXU) { int e, rt, ct; tab[g8::MOE_TAB_UL + tidx] = S.search(tidx, e, rt, ct) ? ((e << 16) | (rt << 8) | ct) : -1; }
    __syncthreads();
    if constexpr (G1 != 0) {
        const int* list = (const int*)(ws + WS_LIST);
#pragma unroll
        for (int j = 0; j < (g8::MOE_MAXU * 256) / 512; ++j) {
            const int idx = tidx + j * 512, i = idx >> 8, r = idx & 255;
            int e, rt, ct;
            if (S.decode(i, e, rt, ct)) { const int ce = tab[g8::MOE_TAB_CNT + e]; int id = rt * 256 + r; id = id < ce ? id : ce - 1; tab[g8::MOE_TAB_ROW + i * 256 + r] = list[e * ECAP + id]; }
        }
        __syncthreads();
        g8::gemm_phase<g8::MoeSched<1>, g8::EpiG1, 1>((LAS unsigned char*)smem, (const char*)(ws + WS_U8), DM, DM / 128, S, g8::EpiG1{(unsigned char*)(ws + WS_ACT), p.in[I_MOE_BGU] + (size_t)layer * NE * 2048}, 0x7A7A7A7A);
    } else {
        g8::gemm_phase<g8::MoeSched<0>, g8::EpiB<4>, 1>((LAS unsigned char*)smem, (const char*)(ws + WS_ACT), DM, DM / 128, S, g8::EpiB<4>{(bf16_t*)(ws + WS_YS), nullptr, nullptr, p.in[I_MOE_BDN] + (size_t)layer * NE * 1024, 0.f, DM, 0}, 0x7D7D7D7D);
    }
    if (layer < 3) {
        int mine = 0;
#pragma unroll
        for (int i = 0; i < g8::MOE_MAXU; ++i) mine += (tab[g8::MOE_TAB_UL + i] >= 0) ? 1 : 0;
        mine = __builtin_amdgcn_readfirstlane(mine);
        int maxu = (S.total + nblk - 1) / nblk;
        if (xl) { const int Wd = G1 ? 8 : 4, NR = S.total / Wd, x = bid & 7; maxu = ((((x + 1) * NR) >> 3) - ((x * NR) >> 3)) * Wd; maxu = (maxu + (nblk >> 3) - 1) / (nblk >> 3); }
        const int target = layer + 1, tb = (target % 3 == 0) ? 2048 : 0;
        int* qh = (int*)(ws + WS_CTL) + CW_QHEAD + target;
        LAS int* slot = (LAS int*)(smem + g8::STAGE_BYTES + 48);
#pragma unroll 1
        for (int k = 0; k < (maxu - mine) * 3; ++k) {
            __syncthreads();
            if (tidx == 0) *slot = atomicAdd(qh, 2);
            __syncthreads();
            const int u = __builtin_amdgcn_readfirstlane(*slot) + tb;
            if (u >= CQ_PER_LAYER) break;
            conv_range(p, smem, target * CQ_PER_LAYER + u, target * CQ_PER_LAYER + (u + 2 < CQ_PER_LAYER ? u + 2 : CQ_PER_LAYER), 0, 1);
        }
    }
}
__device__ __forceinline__ void phase_lru_mid(const Params& p, int slot, unsigned char* smem, int bid, int nblk) {
    const int tid = tid_opaque(), wid = __builtin_amdgcn_readfirstlane(tid >> 6), lane = tid & 63, r32 = lane & 31, hi = lane >> 5;
    unsigned char* ws = p.ws;
    const bf16_t* XBP = (const bf16_t*)(ws + WS_B1); const bf16_t* GG = (const bf16_t*)(ws + WS_B0); bf16_t* Y = (bf16_t*)(ws + WS_B3);
    LAS unsigned char* Al = (LAS unsigned char*)smem;
    LAS float* wAB = (LAS float*)(smem + 69632);
    LAS float* cwl = (LAS float*)(smem + 69632 + 2048);
    LAS unsigned char* wfl = (LAS unsigned char*)(smem + 69632 + 2048 + 2560);
    unsigned char* cvl = smem + 98304;
    const int chunk = tid & 15, rg = tid >> 4;
#pragma unroll 1
    for (int uu = bid; uu < 256; uu += nblk) {
        const int unit = (uu & 7) * 32 + (uu >> 3);
        const int b = unit >> 5, g = (unit >> 2) & 7, s = unit & 3;
        const int c = g * 128 + s * 32 + r32;
        __syncthreads();
        if (tid < 128) {
#pragma unroll
            for (int k = 0; k < 4; ++k) cwl[k * 128 + tid] = p.in[I_LRU_CW][(size_t)(slot * 4 + k) * DM + g * 128 + tid];
            cwl[4 * 128 + tid] = p.in[I_LRU_CB][(size_t)slot * DM + g * 128 + tid];
        }
        if (tid < 64) {
            const bf16_t* wap = (const bf16_t*)(ws + WT_LRU_A) + ((size_t)(slot * 8 + g) * 128 + s * 32 + r32) * 128 + hi * 8;
            const bf16_t* wxp = (const bf16_t*)(ws + WT_LRU_X) + ((size_t)(slot * 8 + g) * 128 + s * 32 + r32) * 128 + hi * 8;
#pragma unroll
            for (int st = 0; st < 8; ++st) { *(LAS bf16x8*)(wfl + (st * 64 + lane) * 16) = *(const bf16x8*)(wap + st * 16); *(LAS bf16x8*)(wfl + ((8 + st) * 64 + lane) * 16) = *(const bf16x8*)(wxp + st * 16); }
        }
        const float ba = p.in[I_LRU_BA][(size_t)slot * DM + c], bx = p.in[I_LRU_BX][(size_t)slot * DM + c];
        const float ca = -8.0f * log1pf(__expf(-p.in[I_LRU_AP][(size_t)slot * DM + c]));
        const float L2E = 1.4426950408889634f, ba2 = -ba * L2E, bx2 = -bx * L2E, ca2 = ca * L2E;
        float hcar = 0.f;
        __syncthreads();
        const int cq0 = slot * 3 * CQ_PER_LAYER + unit * 8;
#pragma unroll 1
        for (int rt = 0; rt < 8; ++rt) {
            const int t0 = b * SEQ + rt * 256;
            u32x4 xr[11];
            {
                const bf16_t* xp = XBP + (size_t)(t0 + rg * 8 - 3) * DM + g * 128 + chunk * 8;
                const bool head = (rt == 0 && rg == 0);
#pragma unroll
                for (int i = 0; i < 11; ++i) { if (i < 3 && head) xr[i] = (u32x4){0u, 0u, 0u, 0u}; else xr[i] = *(const u32x4*)(xp + (size_t)i * DM); }
            }
            const int cq = cq0 + rt; const bool cvalid = true; CqJob CJ; f32x4 cv[8];
            if (cvalid) { convq_decode(p, cq, CJ);
#pragma unroll
                for (int i = 0; i < 8; ++i) cv[i] = __builtin_nontemporal_load((const f32x4*)(CJ.src + (size_t)(CJ.k0 + wid * 8 + i) * CJ.N + CJ.n0 + lane * 4)); }
            bf16_t ggv[16];
#pragma unroll
            for (int r = 0; r < 16; ++r) ggv[r] = GG[(size_t)(t0 + 32 * wid + crow(r, hi)) * DM + c];
            {
                f32x4 w0[4], w1[4];
#pragma unroll
                for (int k = 0; k < 4; ++k) { w0[k] = *(const LAS f32x4*)(cwl + k * 128 + chunk * 8); w1[k] = *(const LAS f32x4*)(cwl + k * 128 + chunk * 8 + 4); }
                const f32x4 bb0 = *(const LAS f32x4*)(cwl + 4 * 128 + chunk * 8), bb1 = *(const LAS f32x4*)(cwl + 4 * 128 + chunk * 8 + 4);
#pragma unroll
                for (int i = 0; i < 8; ++i) {
                    f32x4 o0 = bb0, o1 = bb1;
#pragma unroll
                    for (int k = 0; k < 4; ++k) {
                        const u32x4 x = xr[i + k];
                        f32x4 x0, x1;
                        x0[0] = __uint_as_float(x.x << 16); x0[1] = __uint_as_float(x.x & 0xffff0000u); x0[2] = __uint_as_float(x.y << 16); x0[3] = __uint_as_float(x.y & 0xffff0000u);
                        x1[0] = __uint_as_float(x.z << 16); x1[1] = __uint_as_float(x.z & 0xffff0000u); x1[2] = __uint_as_float(x.w << 16); x1[3] = __uint_as_float(x.w & 0xffff0000u);
                        o0 = o0 + x0 * w0[k]; o1 = o1 + x1 * w1[k];
                    }
                    *(LAS u32x4*)(Al + (rg * 8 + i) * 272 + chunk * 16) = g8::pack8(o0, o1);
                }
            }
            __syncthreads();
            f32x16 ar = {}, ax = {};
#pragma unroll
            for (int st = 0; st < 8; ++st) {
                const bf16x8 a = *(const LAS bf16x8*)(Al + (32 * wid + r32) * 272 + st * 32 + hi * 16);
                ar = __builtin_amdgcn_mfma_f32_32x32x16_bf16(a, *(const LAS bf16x8*)(wfl + (st * 64 + lane) * 16), ar, 0, 0, 0);
                ax = __builtin_amdgcn_mfma_f32_32x32x16_bf16(a, *(const LAS bf16x8*)(wfl + ((8 + st) * 64 + lane) * 16), ax, 0, 0, 0);
            }
            float av[16], bv[16];
#pragma unroll
            for (int r = 0; r < 16; ++r) {
                const float xb = bf2f(*(const LAS bf16_t*)(Al + (32 * wid + crow(r, hi)) * 272 + (s * 32 + r32) * 2));
                const float rgt = g8::fast_rcp(1.0f + __builtin_amdgcn_exp2f(__builtin_fmaf(ar[r], -L2E, ba2))), igt = g8::fast_rcp(1.0f + __builtin_amdgcn_exp2f(__builtin_fmaf(ax[r], -L2E, bx2)));
                const float a = __builtin_amdgcn_exp2f(ca2 * rgt);
                av[r] = a; bv[r] = __builtin_amdgcn_sqrtf(fmaxf(__builtin_fmaf(-a, a, 1.0f), 0.f)) * (igt * xb);
            }
            float GA[4], GB[4], PA[4], PB[4];
#pragma unroll
            for (int gi = 0; gi < 4; ++gi) {
                float A = av[4 * gi], Bq = bv[4 * gi];
#pragma unroll
                for (int k = 1; k < 4; ++k) { Bq = av[4 * gi + k] * Bq + bv[4 * gi + k]; A = av[4 * gi + k] * A; }
                GA[gi] = A; GB[gi] = Bq; PA[gi] = shx(A, 32, lane); PB[gi] = shx(Bq, 32, lane);
            }
            float TA = 1.f, TB = 0.f;
#pragma unroll
            for (int gi = 0; gi < 4; ++gi) {
                const float loA = hi ? PA[gi] : GA[gi], loB = hi ? PB[gi] : GB[gi], hiA = hi ? GA[gi] : PA[gi], hiB = hi ? GB[gi] : PB[gi];
                TB = loA * TB + loB; TA = loA * TA; TB = hiA * TB + hiB; TA = hiA * TA;
            }
            if (hi == 0) { wAB[(wid * 32 + r32) * 2] = TA; wAB[(wid * 32 + r32) * 2 + 1] = TB; }
            if (cvalid) {
#pragma unroll
                for (int i = 0; i < 4; ++i) {
                    f32x4 a, bq; a[0] = cv[0][i] * CJ.sc; a[1] = cv[1][i] * CJ.sc; a[2] = cv[2][i] * CJ.sc; a[3] = cv[3][i] * CJ.sc; bq[0] = cv[4][i] * CJ.sc; bq[1] = cv[5][i] * CJ.sc; bq[2] = cv[6][i] * CJ.sc; bq[3] = cv[7][i] * CJ.sc;
                    *(u32x2*)(cvl + (lane * 4 + i) * 72 + wid * 8) = g8::pack8_fp8(a, bq);
                }
            }
            __syncthreads();
            if (cvalid) {
#pragma unroll
                for (int q4 = 0; q4 < 2; ++q4) {
                    const int nn = q4 * 128 + (tid >> 2), ch = tid & 3;
                    u32x4 w; const u32x2 w0 = *(const u32x2*)(cvl + nn * 72 + ch * 16), w1 = *(const u32x2*)(cvl + nn * 72 + ch * 16 + 8); w.x = w0.x; w.y = w0.y; w.z = w1.x; w.w = w1.y;
                    *(u32x4*)(CJ.dst + (size_t)(CJ.n0 + nn) * 1024 + CJ.k0 + ch * 16) = w;
                }
            }
            float hin = hcar, hall = hcar;
#pragma unroll
            for (int w = 0; w < 8; ++w) {
                const float A = wAB[(w * 32 + r32) * 2], Bq = wAB[(w * 32 + r32) * 2 + 1];
                hall = A * hall + Bq; if (w < wid) hin = hall;
            }
            hcar = hall;
            float h = hin;
#pragma unroll
            for (int gi = 0; gi < 4; ++gi) {
                const float loA = hi ? PA[gi] : GA[gi], loB = hi ? PB[gi] : GB[gi], hiA = hi ? GA[gi] : PA[gi], hiB = hi ? GB[gi] : PB[gi];
                const float hlo = h, hhi = loA * h + loB;
                h = hiA * hhi + hiB;
                float hh = hi ? hhi : hlo;
#pragma unroll
                for (int k = 0; k < 4; ++k) {
                    hh = av[4 * gi + k] * hh + bv[4 * gi + k];
                    Y[(size_t)(t0 + 32 * wid + crow(4 * gi + k, hi)) * DM + c] = f2bf(hh * bf2f(ggv[4 * gi + k]));
                }
            }
        }
    }
}

__device__ __forceinline__ void phase_moe_route_fast(const Params& p, int layer, unsigned char* smem, int bid, int nblk) {
    const int tid = tid_opaque(), wid = __builtin_amdgcn_readfirstlane(tid >> 6), lane = tid & 63, r32 = lane & 31, hi = lane >> 5;
    unsigned char* ws = p.ws;
    const bf16_t* H = (const bf16_t*)(ws + WS_H); unsigned char* U8 = ws + WS_U8;
    const float* g = p.in[I_FFNN] + (size_t)layer * DM; const float* br = p.in[I_MOE_BR] + (size_t)layer * NE;
    const bf16_t* WrT = (const bf16_t*)(ws + WT_ROUTER) + (size_t)layer * NE * DM;
    int* cnt = (int*)(ws + WS_CTL) + CW_CNT + layer * NE; int* list = (int*)(ws + WS_LIST); int* tokslot = (int*)(ws + WS_TOKSLOT); float* gates = (float*)(ws + WS_GATES);
    LAS unsigned char* Ut = (LAS unsigned char*)smem;
    LAS float* part = (LAS float*)(smem + 66048);
    LAS float* lgt = (LAS float*)(smem + 66048 + 32768);
    LAS int* pick_e = (LAS int*)(smem + 66048 + 32768 + 8704);
    LAS int* pick_p = pick_e + 256;
    LAS float* pick_g = (LAS float*)(pick_p + 256);
    LAS int* lcnt = (LAS int*)(pick_g + 256);
#pragma unroll 1
    for (int uu = bid; uu < 256; uu += nblk) {
        const int base = (uu & 7) * 2048 + (uu >> 3) * 64;
        __syncthreads();
        if (tid < 32) lcnt[tid] = 0;
        bf16x8 bw[8];
#pragma unroll
        for (int st = 0; st < 8; ++st) bw[st] = *(const bf16x8*)(WrT + (size_t)r32 * DM + wid * 128 + st * 16 + hi * 8);
        f32x4 gg[4];
#pragma unroll
        for (int q = 0; q < 4; ++q) gg[q] = *(const f32x4*)(g + q * 256 + lane * 4);
        u32x2 hw[4][4], hn[4][4];
#pragma unroll
        for (int j = 0; j < 4; ++j)
#pragma unroll
            for (int q = 0; q < 4; ++q) hw[j][q] = *(const u32x2*)(H + (size_t)(base + wid * 4 + j) * DM + q * 256 + lane * 4);
#pragma unroll
        for (int pass = 0; pass < 2; ++pass) {
            const int tok0 = base + pass * 32;
            if (pass == 0) {
#pragma unroll
                for (int j = 0; j < 4; ++j)
#pragma unroll
                    for (int q = 0; q < 4; ++q) hn[j][q] = *(const u32x2*)(H + (size_t)(base + 32 + wid * 4 + j) * DM + q * 256 + lane * 4);
            }
#pragma unroll
            for (int j = 0; j < 4; ++j) {
                const int row = wid * 4 + j;
                f32x4 v[4]; float ss = 0.f;
#pragma unroll
                for (int q = 0; q < 4; ++q) { const u32x2 w = hw[j][q];
                    v[q][0] = __uint_as_float(w.x << 16); v[q][1] = __uint_as_float(w.x & 0xffff0000u); v[q][2] = __uint_as_float(w.y << 16); v[q][3] = __uint_as_float(w.y & 0xffff0000u);
                    ss += v[q][0] * v[q][0] + v[q][1] * v[q][1] + v[q][2] * v[q][2] + v[q][3] * v[q][3]; }
                ss = wave_sum(ss, lane);
                const float rstd = rsqrtf(ss * (1.0f / 1024.0f) + RMS_EPS);
#pragma unroll
                for (int q = 0; q < 4; ++q) {
                    f32x4 un; un[0] = v[q][0] * rstd * gg[q][0]; un[1] = v[q][1] * rstd * gg[q][1]; un[2] = v[q][2] * rstd * gg[q][2]; un[3] = v[q][3] * rstd * gg[q][3];
                    u32x2 w; w.x = pk2(un[0], un[1]); w.y = pk2(un[2], un[3]);
                    *(LAS u32x2*)(Ut + row * 2064 + (q * 256 + lane * 4) * 2) = w;
                    int w8 = 0; w8 = __builtin_amdgcn_cvt_pk_fp8_f32(g8::clamp448(un[0]), g8::clamp448(un[1]), w8, false); w8 = __builtin_amdgcn_cvt_pk_fp8_f32(g8::clamp448(un[2]), g8::clamp448(un[3]), w8, true);
                    *(int*)(U8 + (size_t)(tok0 + row) * DM + q * 256 + lane * 4) = w8;
                }
            }
            __syncthreads();
            f32x16 acc = {};
#pragma unroll
            for (int st = 0; st < 8; ++st) {
                const int k = wid * 128 + st * 16 + hi * 8;
                const bf16x8 a = *(const LAS bf16x8*)(Ut + r32 * 2064 + k * 2);
                acc = __builtin_amdgcn_mfma_f32_32x32x16_bf16(a, bw[st], acc, 0, 0, 0);
            }
#pragma unroll
            for (int r = 0; r < 16; ++r) part[(wid * 16 + r) * 64 + lane] = acc[r];
            __syncthreads();
#pragma unroll
            for (int o2 = 0; o2 < 2; ++o2) {
                const int o = tid + o2 * 512, r = o >> 6, l = o & 63;
                float s = 0.f;
#pragma unroll
                for (int w = 0; w < 8; ++w) s += part[(w * 16 + r) * 64 + l];
                lgt[pass * 1088 + crow(r, l >> 5) * 33 + (l & 31)] = s + br[l & 31];
            }
            if (pass == 0) {
#pragma unroll
                for (int j = 0; j < 4; ++j)
#pragma unroll
                    for (int q = 0; q < 4; ++q) hw[j][q] = hn[j][q];
            }
        }
        __syncthreads();
        if (tid < 64) {
            float lg[NE];
#pragma unroll
            for (int e = 0; e < NE; ++e) lg[e] = lgt[(tid >> 5) * 1088 + (tid & 31) * 33 + e];
            unsigned used = 0u; float bv[4]; int bi[4];
#pragma unroll
            for (int k = 0; k < TOPK; ++k) {
                float best = -INFINITY; int idx = 0;
#pragma unroll
                for (int e = 0; e < NE; ++e) { const bool ok = !((used >> e) & 1u) && (lg[e] > best); best = ok ? lg[e] : best; idx = ok ? e : idx; }
                used |= 1u << idx; bv[k] = best; bi[k] = idx;
            }
            float w[4], wsum = 0.f;
#pragma unroll
            for (int k = 0; k < TOPK; ++k) { w[k] = __expf(bv[k] - bv[0]); wsum += w[k]; }
            const float inv = 1.0f / wsum;
#pragma unroll
            for (int k = 0; k < TOPK; ++k) {
                const int slot = tid * 4 + k;
                pick_e[slot] = bi[k]; pick_g[slot] = w[k] * inv;
                pick_p[slot] = __hip_atomic_fetch_add(&lcnt[bi[k]], 1, __ATOMIC_RELAXED, __HIP_MEMORY_SCOPE_WORKGROUP);
            }
        }
        __syncthreads();
        if (tid < 32) { const int n = lcnt[tid]; lcnt[32 + tid] = n ? atomicAdd(&cnt[tid], n) : 0; }
        __syncthreads();
        if (tid < 256) {
            const int tl = tid >> 2, e = pick_e[tid], pos = lcnt[32 + e] + pick_p[tid], t = base + tl;
            list[e * ECAP + pos] = t; tokslot[t * 4 + (tid & 3)] = (e << 16) | pos; gates[t * 4 + (tid & 3)] = pick_g[tid];
        }
    }
}

__device__ __forceinline__ void phase_moe_comb_fast(const Params& p, int layer, unsigned char* smem, int bid, int nblk) {
    const int tid = tid_opaque(), wid = __builtin_amdgcn_readfirstlane(tid >> 6), lane = tid & 63;
    unsigned char* ws = p.ws;
    const int* cnt = (const int*)(ws + WS_CTL) + CW_CNT + layer * NE;
    LAS const int* ps = (LAS const int*)(smem + g8::STAGE_BYTES + LDS_MISC_OFF) + g8::MOE_TAB_PS;
    bf16_t* H = (bf16_t*)(ws + WS_H); unsigned char* U = ws + WS_U; const unsigned char* YS = ws + WS_YS;
    const int* tokslot = (const int*)(ws + WS_TOKSLOT); const float* gates = (const float*)(ws + WS_GATES);
    const bool last = (layer == 3);
    const float* g = last ? p.in[I_FINN] : p.in[I_MIXN] + (size_t)(layer + 1) * DM;
    f32x4 gg[2][2];
#pragma unroll
    for (int sg = 0; sg < 2; ++sg) { gg[sg][0] = *(const f32x4*)(g + sg * 512 + lane * 8); gg[sg][1] = *(const f32x4*)(g + sg * 512 + lane * 8 + 4); }
    auto tok_at = [&](int q) __attribute__((always_inline)) { const int uu = bid + (q >> 2) * nblk; return uu < 256 ? (uu & 7) * 2048 + (uu >> 3) * 64 + (q & 3) * 16 + wid * 2 : -1; };
    int slv = 0; float gwv = 0.f;
    { const int tf = tok_at(0); if (tf >= 0) { slv = tokslot[tf * 4 + (lane & 7)]; gwv = gates[tf * 4 + (lane & 7)]; } }
#pragma unroll 1
    for (int q = 0; ; ++q) {
        const int t0 = tok_at(q); if (t0 < 0) break;
        f32x4 v[2][2][2]; u32x2 y[2][4][2]; float gw[2][4];
        const int slc = slv; const float gwc = gwv;
        { const int tn = tok_at(q + 1); if (tn >= 0) { slv = tokslot[tn * 4 + (lane & 7)]; gwv = gates[tn * 4 + (lane & 7)]; } }
#pragma unroll
        for (int a = 0; a < 2; ++a) {
            const int t = t0 + a;
            const bf16_t* hrow = H + (size_t)t * DM;
#pragma unroll
            for (int sg = 0; sg < 2; ++sg) { const u32x4 w = *(const u32x4*)(hrow + sg * 512 + lane * 8);
                v[a][sg][0][0] = __uint_as_float(w.x << 16); v[a][sg][0][1] = __uint_as_float(w.x & 0xffff0000u); v[a][sg][0][2] = __uint_as_float(w.y << 16); v[a][sg][0][3] = __uint_as_float(w.y & 0xffff0000u);
                v[a][sg][1][0] = __uint_as_float(w.z << 16); v[a][sg][1][1] = __uint_as_float(w.z & 0xffff0000u); v[a][sg][1][2] = __uint_as_float(w.w << 16); v[a][sg][1][3] = __uint_as_float(w.w & 0xffff0000u); }
#pragma unroll
            for (int k = 0; k < TOPK; ++k) {
                const int sl = __builtin_amdgcn_readlane(slc, a * 4 + k); gw[a][k] = __int_as_float(__builtin_amdgcn_readlane(__float_as_int(gwc), a * 4 + k)) * 0.0625f;
                const unsigned char* yr = YS + (size_t)(ps[sl >> 16] + (sl & 0xffff)) * DM;
#pragma unroll
                for (int sg = 0; sg < 2; ++sg) y[a][k][sg] = __builtin_nontemporal_load((const u32x2*)(yr + sg * 512 + lane * 8));
            }
        }
#pragma unroll
        for (int a = 0; a < 2; ++a) {
            const int t = t0 + a;
            float ss = 0.f;
#pragma unroll
            for (int sg = 0; sg < 2; ++sg) {
#pragma unroll
                for (int k = 0; k < TOPK; ++k) {
                    const u32x2 w = y[a][k][sg]; const float q = gw[a][k];
                    const f32x2_t p0 = __builtin_amdgcn_cvt_pk_f32_fp8((int)w.x, false), p1 = __builtin_amdgcn_cvt_pk_f32_fp8((int)w.x, true);
                    const f32x2_t p2 = __builtin_amdgcn_cvt_pk_f32_fp8((int)w.y, false), p3 = __builtin_amdgcn_cvt_pk_f32_fp8((int)w.y, true);
                    v[a][sg][0][0] += q * p0[0]; v[a][sg][0][1] += q * p0[1]; v[a][sg][0][2] += q * p1[0]; v[a][sg][0][3] += q * p1[1];
                    v[a][sg][1][0] += q * p2[0]; v[a][sg][1][1] += q * p2[1]; v[a][sg][1][2] += q * p3[0]; v[a][sg][1][3] += q * p3[1];
                }
#pragma unroll
                for (int hh = 0; hh < 2; ++hh)
#pragma unroll
                    for (int j = 0; j < 4; ++j) ss += v[a][sg][hh][j] * v[a][sg][hh][j];
            }
            ss = wave_sum(ss, lane);
            const float rstd = rsqrtf(ss * (1.0f / 1024.0f) + RMS_EPS);
#pragma unroll
            for (int sg = 0; sg < 2; ++sg) {
                const f32x4 o0 = v[a][sg][0] * rstd * gg[sg][0], o1 = v[a][sg][1] * rstd * gg[sg][1];
                if (last) {
                    *(f32x4*)(p.out + (size_t)t * DM + sg * 512 + lane * 8) = o0; *(f32x4*)(p.out + (size_t)t * DM + sg * 512 + lane * 8 + 4) = o1;
                } else {
                    *(u32x4*)(H + (size_t)t * DM + sg * 512 + lane * 8) = g8::pack8(v[a][sg][0], v[a][sg][1]);
                    *(u32x2*)(U + (size_t)t * DM + sg * 512 + lane * 8) = g8::pack8_fp8(o0, o1);
                }
            }
        }
    }
}

__device__ __forceinline__ void phase_sb_attn_fast(const Params& p, int bid, int nblk) {
    const int tid = tid_opaque(), wid = __builtin_amdgcn_readfirstlane(tid >> 6), lane = tid & 63, r32 = lane & 31, hi = lane >> 5;
    unsigned char* ws = p.ws;
    const bf16_t* Q = (const bf16_t*)(ws + WS_B0); const bf16_t* Kp = (const bf16_t*)(ws + WS_B1); const bf16_t* V = (const bf16_t*)(ws + WS_B2); bf16_t* O = (bf16_t*)(ws + WS_B3);
#pragma unroll 1
    for (int uu = bid; uu < 256; uu += nblk)
#pragma unroll 1
    for (int k4 = 0; k4 < 4; ++k4) {
        const int unit = (uu & 7) * 1024 + k4 * 256 + (uu >> 3) * 8 + wid;
        const int qb = unit & 63, h = (unit >> 6) & 15, b = unit >> 10;
        const int q0 = qb * 32; const size_t tb = (size_t)b * SEQ;
        bf16x8 qf[4];
#pragma unroll
        for (int st = 0; st < 4; ++st) qf[st] = *(const bf16x8*)(Q + (tb + q0 + r32) * DM + h * HD + st * 16 + hi * 8);
        f32x16 o0 = {}, o1 = {};
        float carry = 1.0f;
        bf16x8 kf[4];
        {
            const bf16_t* kp = Kp + (tb + q0 + r32) * DM + h * HD + hi * 8;
#pragma unroll
            for (int st = 0; st < 4; ++st) kf[st] = *(const bf16x8*)(kp + st * 16);
        }
#pragma unroll 1
        for (int kt = qb; kt >= 0; --kt) {
            const int kbase = kt * 32;
            bf16x8 vf[2][2];
            {
                const bf16_t* vp = V + (tb + kbase + 4 * hi) * DM + h * HD + r32;
#pragma unroll
                for (int s = 0; s < 2; ++s)
#pragma unroll
                    for (int d0 = 0; d0 < 2; ++d0)
#pragma unroll
                        for (int j = 0; j < 8; ++j) vf[s][d0][j] = (short)vp[(size_t)(16 * s + 8 * (j >> 2) + (j & 3)) * DM + d0 * 32];
            }
            f32x16 sc = {};
#pragma unroll
            for (int st = 0; st < 4; ++st) sc = __builtin_amdgcn_mfma_f32_32x32x16_bf16(kf[st], qf[st], sc, 0, 0, 0);
            if (kt > 0) {
                const bf16_t* kp = Kp + (tb + kbase - 32 + r32) * DM + h * HD + hi * 8;
#pragma unroll
                for (int st = 0; st < 4; ++st) kf[st] = *(const bf16x8*)(kp + st * 16);
            }
            float rr[16];
#pragma unroll
            for (int r = 0; r < 16; ++r) {
                const float e = __builtin_amdgcn_exp2f(sc[r]);
                float x = __builtin_amdgcn_rcpf(1.0f + e);
                if (kt == qb) x = (crow(r, hi) < r32) ? x : 1.0f;
                rr[r] = x;
            }
            float G[4], P[4];
#pragma unroll
            for (int gi = 0; gi < 4; ++gi) { G[gi] = (rr[4 * gi] * rr[4 * gi + 1]) * (rr[4 * gi + 2] * rr[4 * gi + 3]); P[gi] = shx(G[gi], 32, lane); }
            float cur = carry, av[16];
#pragma unroll
            for (int gi = 3; gi >= 0; --gi) {
                const float hiP = hi ? G[gi] : P[gi], loP = hi ? P[gi] : G[gi];
                const float ent_hi = cur; cur *= hiP; const float ent_lo = cur; cur *= loP;
                float s_cur = hi ? ent_hi : ent_lo;
#pragma unroll
                for (int k = 3; k >= 0; --k) { const float s_next = s_cur * rr[4 * gi + k]; av[4 * gi + k] = s_cur - s_next; s_cur = s_next; }
            }
            carry = cur;
            bf16x8 pf[2];
#pragma unroll
            for (int s = 0; s < 2; ++s) {
                u32x4 w; w.x = pk2(av[8 * s], av[8 * s + 1]); w.y = pk2(av[8 * s + 2], av[8 * s + 3]); w.z = pk2(av[8 * s + 4], av[8 * s + 5]); w.w = pk2(av[8 * s + 6], av[8 * s + 7]);
                pf[s] = __builtin_bit_cast(bf16x8, w);
            }
            o0 = __builtin_amdgcn_mfma_f32_32x32x16_bf16(pf[0], vf[0][0], o0, 0, 0, 0);
            o1 = __builtin_amdgcn_mfma_f32_32x32x16_bf16(pf[0], vf[0][1], o1, 0, 0, 0);
            o0 = __builtin_amdgcn_mfma_f32_32x32x16_bf16(pf[1], vf[1][0], o0, 0, 0, 0);
            o1 = __builtin_amdgcn_mfma_f32_32x32x16_bf16(pf[1], vf[1][1], o1, 0, 0, 0);
            if (__all(carry == 0.0f)) break;
        }
#pragma unroll
        for (int r = 0; r < 16; ++r) {
            bf16_t* op = O + (tb + q0 + crow(r, hi)) * DM + h * HD + r32;
            op[0] = f2bf(o0[r]); op[32] = f2bf(o1[r]);
        }
    }
}

__device__ __forceinline__ void unpack8(const u32x4& x, float (&f)[8]) {
    f[0] = __uint_as_float(x.x << 16); f[1] = __uint_as_float(x.x & 0xffff0000u); f[2] = __uint_as_float(x.y << 16); f[3] = __uint_as_float(x.y & 0xffff0000u);
    f[4] = __uint_as_float(x.z << 16); f[5] = __uint_as_float(x.z & 0xffff0000u); f[6] = __uint_as_float(x.w << 16); f[7] = __uint_as_float(x.w & 0xffff0000u);
}
template <int WIN>
__device__ __forceinline__ void pool_tile_w(const Params& p, int pm, int g) {
    const int tid = tid_opaque();
    unsigned char* ws = p.ws;
    const bf16_t* v = (const bf16_t*)(ws + WS_B0); bf16_t* pb = (bf16_t*)(ws + WS_B1);
    const int chunk = tid & 31, rb = tid >> 5;
    const int c0 = g * 256 + chunk * 8;
#pragma unroll 1
    for (int half = 0; half < 2; ++half) {
        const int t0 = pm * 256 + rb * 16 + half * 8, pos0 = t0 & (SEQ - 1);
        u32x4 rows[WIN - 1 + 8];
#pragma unroll
        for (int i = 0; i < WIN - 1 + 8; ++i) {
            const int d = i - (WIN - 1);
            if (pos0 + d >= 0) rows[i] = *(const u32x4*)(v + (size_t)(t0 + d) * DM + c0); else rows[i] = (u32x4){0u, 0u, 0u, 0u};
        }
        float s[8];
#pragma unroll
        for (int j = 0; j < 8; ++j) s[j] = 0.f;
#pragma unroll
        for (int i = 0; i < WIN - 1; ++i) { float f[8]; unpack8(rows[i], f);
#pragma unroll
            for (int j = 0; j < 8; ++j) s[j] += f[j]; }
#pragma unroll
        for (int i = 0; i < 8; ++i) {
            const int pos = pos0 + i;
            float xv[8]; unpack8(rows[WIN - 1 + i], xv);
#pragma unroll
            for (int j = 0; j < 8; ++j) s[j] += xv[j];
            const int n = pos + 1 < WIN ? pos + 1 : WIN; const float inv = g8::fast_rcp((float)n); const float inv2 = inv * (2.0f - (float)n * inv);
            f32x4 o0, o1;
#pragma unroll
            for (int j = 0; j < 4; ++j) { o0[j] = s[j] * inv2 - xv[j]; o1[j] = s[4 + j] * inv2 - xv[4 + j]; }
            *(u32x4*)(pb + (size_t)(t0 + i) * DM + c0) = g8::pack8(o0, o1);
            float lv[8]; unpack8(rows[i], lv);
#pragma unroll
            for (int j = 0; j < 8; ++j) s[j] -= lv[j];
        }
    }
    asm volatile("s_waitcnt vmcnt(0)" ::: "memory");
    __syncthreads();
}
__device__ __forceinline__ void pool_tile(const Params& p, int pm, int g) {
    if (g == 0) pool_tile_w<2>(p, pm, g); else if (g == 1) pool_tile_w<4>(p, pm, g); else if (g == 2) pool_tile_w<8>(p, pm, g); else pool_tile_w<16>(p, pm, g);
}

__device__ __forceinline__ unsigned char* opq(unsigned char* q) {
    const unsigned long long v = (unsigned long long)q;
    unsigned lo = (unsigned)__builtin_amdgcn_readfirstlane((int)(unsigned)v), hi = (unsigned)__builtin_amdgcn_readfirstlane((int)(unsigned)(v >> 32));
    asm volatile("" : "+s"(lo), "+s"(hi));
    return (unsigned char*)(((unsigned long long)hi << 32) | lo);
}
#define XB_TMO      128
#define XB_XCNT(j)  (256  + 64 * (j))
#define XB_XSUB(j)  (1280 + 64 * (j))
#define XB_XGEN(j)  (2304 + 64 * (j))
#define XB_TOP      3328
#define XB_TOPGEN   3392
#define XCD_BAR_WORDS 3456
#define XB_SPIN_CAP (1u << 21)
__device__ __forceinline__ unsigned xb_ld(unsigned* p)              { return __hip_atomic_load(p, __ATOMIC_RELAXED, __HIP_MEMORY_SCOPE_AGENT); }
__device__ __forceinline__ unsigned xb_add(unsigned* p, unsigned v) { return __hip_atomic_fetch_add(p, v, __ATOMIC_RELAXED, __HIP_MEMORY_SCOPE_AGENT); }
__device__ __forceinline__ unsigned xb_xcc_id() { return (unsigned)__builtin_amdgcn_s_getreg((3 << 11) | 20) & 0xFu; }
#define XB_SPIN(cond, bar) do { unsigned _sp = 0; while (cond) { __builtin_amdgcn_s_sleep(1); \
    if ((++_sp & 255u) == 0u) { if (xb_ld(&(bar)[XB_TMO])) break; if (_sp > XB_SPIN_CAP) { atomicAdd(&(bar)[XB_TMO], 1u); break; } } } } while (0)
struct XcdBarrier { unsigned* bar; unsigned x; volatile LAS unsigned* st; };
__device__ __forceinline__ XcdBarrier xcd_barrier_post(unsigned* bar, volatile LAS unsigned* st) {
    XcdBarrier b; b.bar = bar; b.x = xb_xcc_id(); b.st = st;
    if (threadIdx.x == 0) st[3] = xb_add(&bar[XB_XCNT(b.x)], 1u);
    return b;
}
__device__ __forceinline__ void xcd_barrier_complete(unsigned* bar, unsigned x, unsigned& nloc, unsigned& nx, unsigned& even) {
    const unsigned G = gridDim.x * gridDim.y * gridDim.z;
    unsigned sum, cnt, mine, c32, sp = 0u;
    for (;;) {
        sum = 0u; cnt = 0u; mine = 0u; c32 = 0u;
#pragma unroll
        for (unsigned j = 0; j < 16; ++j) { const unsigned c = xb_ld(&bar[XB_XCNT(j)]); sum += c; cnt += (c > 0u) ? 1u : 0u; mine = (j == x) ? c : mine; c32 += (j < 8u && c == 32u) ? 1u : 0u; }
        if (sum == G) break;
        __builtin_amdgcn_s_sleep(1);
        if ((++sp & 255u) == 0u) { if (xb_ld(&bar[XB_TMO])) break; if (sp > XB_SPIN_CAP) { atomicAdd(&bar[XB_TMO], 1u); break; } }
    }
    nloc = mine > 0u ? mine : 1u; nx = cnt > 0u ? cnt : 1u; even = (c32 == 8u && sum == 256u) ? 1u : 0u;
}
__device__ __forceinline__ void xcd_barrier(unsigned char* wsb, unsigned char* smem, bool local = false) {
    asm volatile("s_waitcnt vmcnt(0)" ::: "memory");
    __syncthreads();
    if (tid_opaque() == 0) {
        unsigned* bar = (unsigned*)opq(wsb + WS_CTL);
        volatile LAS unsigned* st = (volatile LAS unsigned*)(smem + g8::STAGE_BYTES);
        unsigned bx = xb_xcc_id(); asm volatile("" : "+s"(bx));
        __builtin_amdgcn_s_waitcnt(0);
        unsigned nloc = st[0], nx = st[1];
        if (nloc == 0u) { unsigned even; xcd_barrier_complete(bar, bx, nloc, nx, even); st[0] = nloc; st[1] = nx; st[2] = even; }
        const unsigned old = xb_add(&bar[XB_XSUB(bx)], 1u);
        const unsigned gen = old / nloc;
        if (old + 1u == (gen + 1u) * nloc) {
            if (!local) {
                __builtin_amdgcn_fence(__ATOMIC_RELEASE, "agent");
                asm volatile("s_waitcnt vmcnt(0)" ::: "memory");
                const unsigned og = xb_add(&bar[XB_TOP], 1u);
                const unsigned tg = og / nx;
                if (og + 1u == (tg + 1u) * nx) xb_add(&bar[XB_TOPGEN], 1u);
                else XB_SPIN(xb_ld(&bar[XB_TOPGEN]) == tg, bar);
            }
            __builtin_amdgcn_fence(__ATOMIC_ACQUIRE, "agent");
            xb_add(&bar[XB_XGEN(bx)], 1u);
            asm volatile("s_waitcnt vmcnt(0)" ::: "memory");
        } else {
            XB_SPIN(xb_ld(&bar[XB_XGEN(bx)]) == gen, bar);
            __builtin_amdgcn_fence(__ATOMIC_ACQUIRE, "agent");
            asm volatile("s_waitcnt vmcnt(0)" ::: "memory");
        }
    }
    __syncthreads();
}

constexpr int LDS_BYTES = 147456;
constexpr int LDS_MISC = 64 + 1024 + 10240;

__global__ void __launch_bounds__(512, 2) mega_fwd(Params p) {
    extern __shared__ __attribute__((aligned(16))) unsigned char smem[];
    if ((threadIdx.x & 63) == 0) *(volatile LAS unsigned*)(LDS_WTAB + (threadIdx.x >> 6) * 4u) = hw_slot_id();
    if (threadIdx.x == 0) *(u32x4*)(smem + g8::STAGE_BYTES) = (u32x4){0u, 0u, 0u, 0u};
    __syncthreads();
    (void)xcd_barrier_post((unsigned*)(p.ws + WS_CTL), (volatile LAS unsigned*)(smem + g8::STAGE_BYTES));
    int bid = blockIdx.x; const int nblk = gridDim.x; bool xl = false;
#define GRID_BAR() xcd_barrier(p.ws, smem)
#define SEAM_BAR() xcd_barrier(p.ws, smem, xl)
#define RING ((LAS unsigned char*)smem)
#define WSB(off) ((bf16_t*)(ws + (off)))
    phase_prep(p, smem, bid, nblk);
    GRID_BAR();
    { volatile LAS unsigned* st = (volatile LAS unsigned*)(smem + g8::STAGE_BYTES);
      const unsigned even = (unsigned)__builtin_amdgcn_readfirstlane((int)st[2]), rk = (unsigned)__builtin_amdgcn_readfirstlane((int)st[3]);
      xl = (even != 0u) && (nblk == 256);
      if (xl) bid = (int)(rk * 8u + xb_xcc_id()); }
#pragma unroll 1
    for (int layer = 0; layer < 4; ++layer) {
        const int kind = layer % 3, slot = layer / 3;
        const bool cfirst = xl && (bid & 1);
#define CONV_LAYER() do { const int tb = (layer % 3 == 0) ? 2048 : 0; int done = ((const int*)(p.ws + WS_CTL))[CW_QHEAD + layer]; done = __builtin_amdgcn_readfirstlane(done); done = done < CQ_PER_LAYER - tb ? done : CQ_PER_LAYER - tb; \
          conv_range(p, smem, layer * CQ_PER_LAYER + tb + done, (layer + 1) * CQ_PER_LAYER, bid, nblk); } while (0)
#pragma unroll 1
        for (int cstep = 0; cstep < 2; ++cstep) {
        if (cstep == (cfirst ? 0 : 1)) CONV_LAYER();
        if (cstep == 0) {
        if (kind == 0) {
            { unsigned char* ws = opq(p.ws);
              g8::DenseSched S; S.init(T_TOK, 2048, nblk, bid, DM, (const unsigned char*)(ws + WT_LRU_IN) + (size_t)slot * 2048 * 1024, DM, 0);
              g8::gemm_phase<g8::DenseSched, g8::EpiB<1>, 1>(RING, (const char*)(ws + WS_U), DM, DM / 128, S, g8::EpiB<1>{WSB(WS_B0), WSB(WS_B1), nullptr, nullptr, 0.f, DM, 0}, 0x7A7A7A7A); }
            SEAM_BAR();
            phase_lru_mid(p, slot, smem, bid, nblk);
            SEAM_BAR();
            { unsigned char* ws = opq(p.ws); const float* hin = (layer == 0) ? p.in[I_X] : nullptr;
              g8::DenseSched S; S.init(T_TOK, 1024, nblk, bid, DM * 2, WSB(WT_LRU_OUT) + (size_t)slot * 1024 * 1024, DM * 2, 0);
              g8::gemm_phase(RING, (const char*)WSB(WS_B3), DM * 2, DM / 64, S, g8::EpiRes{hin, WSB(WS_H), WSB(WS_H)}); }
            SEAM_BAR();
        } else if (kind == 1) {
            { unsigned char* ws = opq(p.ws);
              g8::DenseSched S; S.init(T_TOK, 1024, nblk, bid, DM, (const unsigned char*)(ws + WT_POOL_IN), DM, 0);
              g8::gemm_phase<g8::DenseSched, g8::EpiB<0>, 1>(RING, (const char*)(ws + WS_U), DM, DM / 128, S, g8::EpiB<0>{WSB(WS_B0), nullptr, nullptr, nullptr, 0.f, DM, 0}, 0x7A7A7A7A); }
            SEAM_BAR();
            { unsigned char* ws = opq(p.ws);
              for (int uu = bid; uu < 256; uu += nblk) { const int L = (uu & 7) * 32 + (uu >> 3); pool_tile(p, L >> 2, L & 3); }
              g8::PoolGrpSched S; S.G = nblk; S.c = bid; S.Wg = (const char*)(ws + WT_POOL_G);
              g8::gemm_phase(RING, (const char*)WSB(WS_B1), 256 * 2, 256 / 64, S, g8::EpiB<3>{WSB(WS_B2), nullptr, nullptr, p.in[I_POOL_SC], 0.f, DM, 0}); }
            SEAM_BAR();
            { unsigned char* ws = opq(p.ws); const float* hin = nullptr;
              g8::DenseSched S; S.init(T_TOK, 1024, nblk, bid, DM * 2, WSB(WT_POOL_OUT), DM * 2, 0);
              g8::gemm_phase(RING, (const char*)WSB(WS_B2), DM * 2, DM / 64, S, g8::EpiRes{hin, WSB(WS_H), WSB(WS_H)}); }
            SEAM_BAR();
        } else {
            { unsigned char* ws = opq(p.ws);
              g8::DenseSched S; S.init(T_TOK, 3072, nblk, bid, DM, (const unsigned char*)(ws + WT_QKV), DM, 0);
              g8::gemm_phase<g8::DenseSched, g8::EpiB<2>, 1>(RING, (const char*)(ws + WS_U), DM, DM / 128, S, g8::EpiB<2>{WSB(WS_B0), WSB(WS_B1), WSB(WS_B2), nullptr, 0.125f * 1.4426950408889634f, DM, 0}, 0x7A7A7A7A); }
            SEAM_BAR();
            phase_sb_attn_fast(p, bid, nblk);
            SEAM_BAR();
            { unsigned char* ws = opq(p.ws); const float* hin = nullptr;
              g8::DenseSched S; S.init(T_TOK, 1024, nblk, bid, DM * 2, WSB(WT_SB_OUT), DM * 2, 0);
              g8::gemm_phase(RING, (const char*)WSB(WS_B3), DM * 2, DM / 64, S, g8::EpiRes{hin, WSB(WS_H), WSB(WS_H)}); }
            SEAM_BAR();
        }
        phase_moe_route_fast(p, layer, smem, bid, nblk);
        } }
        GRID_BAR();
        phase_moe_gemm_fast<1>(p, layer, smem, bid, nblk, xl);
        SEAM_BAR();
        phase_moe_gemm_fast<0>(p, layer, smem, bid, nblk, xl);
        GRID_BAR();
        phase_moe_comb_fast(p, layer, smem, bid, nblk);
        if (layer < 3) SEAM_BAR();
    }
#undef GRID_BAR
#undef SEAM_BAR
#undef CONV_LAYER
}

extern "C" void kernel_launch(void* const* d_in, const int* in_sizes, int n_in, void* d_out, int out_size, void* d_ws, size_t ws_size, hipStream_t stream) {
    Params p{};
    for (int i = 0; i < 25; ++i) p.in[i] = (const float*)d_in[i];
    p.out = (float*)d_out; p.ws = (unsigned char*)d_ws;
    static int grid = 0;
    if (!grid) {
        int dev = 0, cus = 0, per_cu = 0;
        (void)hipGetDevice(&dev);
        (void)hipDeviceGetAttribute(&cus, hipDeviceAttributeMultiprocessorCount, dev);
        (void)hipFuncSetAttribute((const void*)mega_fwd, hipFuncAttributeMaxDynamicSharedMemorySize, LDS_BYTES);
        (void)hipOccupancyMaxActiveBlocksPerMultiprocessor(&per_cu, (const void*)mega_fwd, 512, LDS_BYTES);
        grid = cus * (per_cu < 1 ? per_cu : 1);
        if (grid <= 0) grid = 1;
    }
    (void)hipMemsetAsync(d_ws, 0, 1 * MB, stream);
    hipLaunchKernelGGL(mega_fwd, dim3(grid), dim3(512), LDS_BYTES, stream, p);
}
```

```cpp
#include <hip/hip_runtime.h>
#include <stdint.h>

typedef unsigned short bf16_t;
typedef short bf16x8 __attribute__((ext_vector_type(8)));
typedef float f32x16 __attribute__((ext_vector_type(16)));
typedef float f32x4 __attribute__((ext_vector_type(4)));
typedef float f32x2_t __attribute__((ext_vector_type(2)));
typedef __bf16 bf16x2_t __attribute__((ext_vector_type(2)));
typedef unsigned u32x4 __attribute__((ext_vector_type(4)));
typedef unsigned u32x2 __attribute__((ext_vector_type(2)));

constexpr int T_TOK = 16384, DM = 1024, SEQ = 2048, NB = 8, NE = 32, TOPK = 4, NH = 16, HD = 64;
constexpr float SWI_C = 2.4554669595930157f;
constexpr int ECAP = 16384;
constexpr int PADROWS = 65536 + 32 * 256;
constexpr float RMS_EPS = 1e-6f;

constexpr size_t MB = 1024ull * 1024ull;
constexpr size_t WS_CTL = 0;
constexpr size_t WS_LIST = 1 * MB;
constexpr size_t WS_TOKSLOT = 3 * MB;
constexpr size_t WS_GATES = 4 * MB;
constexpr size_t WS_H = 8 * MB;
constexpr size_t WS_U = WS_H + 64 * MB;
constexpr size_t WS_B0 = WS_U + 32 * MB;
constexpr size_t WS_U8 = WS_U + 16 * MB;
constexpr size_t WS_B1 = WS_B0 + 32 * MB;
constexpr size_t WS_B2 = WS_B1 + 32 * MB;
constexpr size_t WS_B3 = WS_B2 + 32 * MB;
constexpr size_t WS_ACT = WS_B3 + 32 * MB;
constexpr size_t WS_YS = WS_ACT + 160 * MB;
constexpr size_t WS_W = WS_YS + 160 * MB;
constexpr size_t WT_LRU_IN = WS_W;
constexpr size_t WT_LRU_OUT = WT_LRU_IN + 8 * MB;
constexpr size_t WT_POOL_IN = WT_LRU_OUT + 4 * MB;
constexpr size_t WT_POOL_G = WT_POOL_IN + 2 * MB;
constexpr size_t WT_POOL_OUT = WT_POOL_G + 1 * MB;
constexpr size_t WT_QKV = WT_POOL_OUT + 2 * MB;
constexpr size_t WT_SB_OUT = WT_QKV + 6 * MB;
constexpr size_t WT_LRU_A = WT_SB_OUT + 2 * MB;
constexpr size_t WT_LRU_X = WT_LRU_A + 1 * MB;
constexpr size_t WT_ROUTER = WT_LRU_X + 1 * MB;
constexpr size_t WT_GU = WT_ROUTER + 1 * MB;
constexpr size_t WT_DN = WT_GU + 512 * MB;
constexpr size_t WS_END = WT_DN + 256 * MB;
constexpr int CW_CNT = 8192;

struct Params {
    const float* in[25];
    float* out;
    unsigned char* ws;
};
enum { I_X = 0, I_MIXN, I_FFNN, I_FINN, I_LRU_WIN, I_LRU_CW, I_LRU_CB, I_LRU_WA, I_LRU_BA, I_LRU_WX, I_LRU_BX, I_LRU_AP, I_LRU_WOUT,
       I_POOL_WIN, I_POOL_WG, I_POOL_SC, I_POOL_WOUT, I_SB_WQKV, I_SB_WOUT, I_MOE_WR, I_MOE_BR, I_MOE_WGU, I_MOE_BGU, I_MOE_WDN, I_MOE_BDN };

constexpr unsigned LDS_WTAB = 147456u - 64u;
__device__ __forceinline__ unsigned hw_slot_id() { return (unsigned)__builtin_amdgcn_s_getreg(((16 - 1) << 11) | 4); }
__device__ __forceinline__ int tid_opaque() {
    const unsigned hw = hw_slot_id();
    unsigned m = ~0u; asm volatile("" : "+s"(m));
    const int lane = (int)__builtin_amdgcn_mbcnt_hi(m, __builtin_amdgcn_mbcnt_lo(m, 0u));
    const unsigned ent = *(const volatile __attribute__((address_space(3))) unsigned*)(LDS_WTAB + (unsigned)(lane & 7) * 4u);
    const int wi = __builtin_ctzll(__builtin_amdgcn_ballot_w64(ent == hw));
    int t = wi * 64 + lane; asm volatile("" : "+v"(t)); return t;
}
__device__ __forceinline__ float bf2f(bf16_t b) { return __uint_as_float(((unsigned)b) << 16); }
__device__ __forceinline__ unsigned pk2(float lo, float hi) { f32x2_t v = {lo, hi}; bf16x2_t b = __builtin_convertvector(v, bf16x2_t); return __builtin_bit_cast(unsigned, b); }
__device__ __forceinline__ bf16_t f2bf(float f) { return (bf16_t)(pk2(f, 0.f) & 0xffffu); }
__device__ __forceinline__ int crow(int r, int hi) { return (r & 3) + 8 * (r >> 2) + 4 * hi; }
__device__ __forceinline__ float shx(float v, int o, int lane) { return __int_as_float(__builtin_amdgcn_ds_bpermute((lane ^ o) << 2, __float_as_int(v))); }
__device__ __forceinline__ float wave_sum(float v, int lane) {
#pragma unroll
    for (int o = 32; o >= 1; o >>= 1) v += shx(v, o, lane);
    return v;
}
__device__ __forceinline__ void convT_small(const float* src, bf16_t* dst, int nbat, int K, int N, int bid, int nblk) {
    const int tidx = tid_opaque();
    const size_t total = (size_t)nbat * K * N;
    for (size_t i = (size_t)bid * blockDim.x + tidx; i < total; i += (size_t)nblk * blockDim.x) {
        const size_t m = i / ((size_t)K * N), r = i % ((size_t)K * N);
        const int n = (int)(r / K), k = (int)(r % K);
        dst[i] = f2bf(src[m * K * N + (size_t)k * N + n]);
    }
}

__device__ __forceinline__ void norm_row_wave(const float* __restrict__ xrow, const float* __restrict__ g, bf16_t* __restrict__ orow, int lane) {
    f32x4 v[4]; float ss = 0.f;
#pragma unroll
    for (int j = 0; j < 4; ++j) { v[j] = *(const f32x4*)(xrow + j * 256 + lane * 4); ss += v[j][0] * v[j][0] + v[j][1] * v[j][1] + v[j][2] * v[j][2] + v[j][3] * v[j][3]; }
    ss = wave_sum(ss, lane);
    const float rstd = rsqrtf(ss * (1.0f / 1024.0f) + RMS_EPS);
#pragma unroll
    for (int j = 0; j < 4; ++j) {
        const f32x4 gg = *(const f32x4*)(g + j * 256 + lane * 4);
        u32x2 w; w.x = pk2(v[j][0] * rstd * gg[0], v[j][1] * rstd * gg[1]); w.y = pk2(v[j][2] * rstd * gg[2], v[j][3] * rstd * gg[3]);
        *(u32x2*)(orow + j * 256 + lane * 4) = w;
    }
}

__device__ __forceinline__ float clamp448_early(float x) { return __builtin_fminf(__builtin_fmaxf(x, -448.0f), 448.0f); }
__device__ __forceinline__ u32x2 pack8_fp8_early(const f32x4& a, const f32x4& b) {
    int w0 = 0, w1 = 0;
    w0 = __builtin_amdgcn_cvt_pk_fp8_f32(clamp448_early(a[0]), clamp448_early(a[1]), w0, false); w0 = __builtin_amdgcn_cvt_pk_fp8_f32(clamp448_early(a[2]), clamp448_early(a[3]), w0, true);
    w1 = __builtin_amdgcn_cvt_pk_fp8_f32(clamp448_early(b[0]), clamp448_early(b[1]), w1, false); w1 = __builtin_amdgcn_cvt_pk_fp8_f32(clamp448_early(b[2]), clamp448_early(b[3]), w1, true);
    u32x2 r; r.x = (unsigned)w0; r.y = (unsigned)w1; return r;
}
struct PrepJob { const float* src; bf16_t* dst; int K, N; int k0, n0; int f8; };
__device__ __forceinline__ bool prep_decode(const Params& p, int u, PrepJob& J) {
    unsigned char* ws = p.ws;
    const int idx[7] = {I_LRU_WIN, I_LRU_WOUT, I_POOL_WIN, I_POOL_WG, I_POOL_WOUT, I_SB_WQKV, I_SB_WOUT};
    const size_t off[7] = {WT_LRU_IN, WT_LRU_OUT, WT_POOL_IN, WT_POOL_G, WT_POOL_OUT, WT_QKV, WT_SB_OUT};
    const int nbat[7] = {2, 2, 1, 4, 1, 1, 1};
    const int Ks[7] = {1024, 1024, 1024, 256, 1024, 1024, 1024};
    const int Ns[7] = {2048, 1024, 1024, 256, 1024, 3072, 1024};
    const int F8[7] = {1, 0, 1, 0, 0, 1, 0};
    int rem = u;
#pragma unroll
    for (int j = 0; j < 7; ++j) {
        const int ntl = Ns[j] / 256, per = (Ks[j] / 64) * ntl, tot = nbat[j] * per;
        if (rem < tot) {
            const int m = rem / per, r = rem % per;
            J.src = p.in[idx[j]] + (size_t)m * Ks[j] * Ns[j]; J.f8 = F8[j];
            J.dst = F8[j] ? (bf16_t*)(ws + off[j] + (size_t)m * Ks[j] * Ns[j]) : (bf16_t*)(ws + off[j]) + (size_t)m * Ks[j] * Ns[j];
            J.K = Ks[j]; J.N = Ns[j]; J.k0 = (r / ntl) * 64; J.n0 = (r % ntl) * 256; return true;
        }
        rem -= tot;
    }
    return false;
}
__device__ __forceinline__ void phase_prep(const Params& p, unsigned char* lds, int bid, int nblk) {
    const int tidx = tid_opaque();
    unsigned char* ws = p.ws;
    const int lane = tidx & 63, kg = tidx >> 6;
    {
        PrepJob J, Jn; f32x4 v[8], vn[8];
        bool have = prep_decode(p, bid, J);
        if (have) {
#pragma unroll
            for (int j = 0; j < 8; ++j) v[j] = *(const f32x4*)(J.src + (size_t)(J.k0 + kg * 8 + j) * J.N + J.n0 + lane * 4);
        }
#pragma unroll 1
        for (int u = bid; have; u += nblk) {
            const bool hn = prep_decode(p, u + nblk, Jn);
            if (hn) {
#pragma unroll
                for (int j = 0; j < 8; ++j) vn[j] = *(const f32x4*)(Jn.src + (size_t)(Jn.k0 + kg * 8 + j) * Jn.N + Jn.n0 + lane * 4);
            }
            if (J.f8) {
#pragma unroll
                for (int i = 0; i < 4; ++i) {
                    f32x4 a, b; a[0] = v[0][i] * 32.0f; a[1] = v[1][i] * 32.0f; a[2] = v[2][i] * 32.0f; a[3] = v[3][i] * 32.0f; b[0] = v[4][i] * 32.0f; b[1] = v[5][i] * 32.0f; b[2] = v[6][i] * 32.0f; b[3] = v[7][i] * 32.0f;
                    *(u32x2*)(lds + (lane * 4 + i) * 72 + kg * 8) = pack8_fp8_early(a, b);
                }
                __syncthreads();
#pragma unroll
                for (int q = 0; q < 2; ++q) {
                    const int n = q * 128 + (tidx >> 2), ch = tidx & 3;
                    u32x4 w; const u32x2 w0 = *(const u32x2*)(lds + n * 72 + ch * 16), w1 = *(const u32x2*)(lds + n * 72 + ch * 16 + 8); w.x = w0.x; w.y = w0.y; w.z = w1.x; w.w = w1.y;
                    *(u32x4*)((unsigned char*)J.dst + (size_t)(J.n0 + n) * J.K + J.k0 + ch * 16) = w;
                }
            } else {
#pragma unroll
            for (int i = 0; i < 4; ++i) {
                u32x4 w;
                w.x = pk2(v[0][i], v[1][i]); w.y = pk2(v[2][i], v[3][i]); w.z = pk2(v[4][i], v[5][i]); w.w = pk2(v[6][i], v[7][i]);
                *(u32x4*)(lds + (lane * 4 + i) * 144 + kg * 16) = w;
            }
            __syncthreads();
#pragma unroll
            for (int q = 0; q < 4; ++q) {
                const int n = q * 64 + (tidx >> 3), ch = tidx & 7;
                const u32x4 w = *(const u32x4*)(lds + n * 144 + ch * 16);
                *(u32x4*)(J.dst + (size_t)(J.n0 + n) * J.K + J.k0 + ch * 8) = w;
            }
            }
            __syncthreads();
            have = hn; J = Jn;
#pragma unroll
            for (int j = 0; j < 8; ++j) v[j] = vn[j];
        }
    }
    convT_small(p.in[I_LRU_WA], (bf16_t*)(ws + WT_LRU_A), 16, 128, 128, bid, nblk);
    convT_small(p.in[I_LRU_WX], (bf16_t*)(ws + WT_LRU_X), 16, 128, 128, bid, nblk);
    convT_small(p.in[I_MOE_WR], (bf16_t*)(ws + WT_ROUTER), 4, 1024, 32, bid, nblk);
    const int wid = tidx >> 6, nw = blockDim.x >> 6;
    f32x4 gg[4];
#pragma unroll
    for (int j = 0; j < 4; ++j) gg[j] = *(const f32x4*)(p.in[I_MIXN] + j * 256 + lane * 4);
#pragma unroll 1
    for (int t0 = (bid * nw + wid) * 4; t0 < T_TOK; t0 += nblk * nw * 4) {
        f32x4 v[4][4];
#pragma unroll
        for (int a = 0; a < 4; ++a)
#pragma unroll
            for (int j = 0; j < 4; ++j) v[a][j] = *(const f32x4*)(p.in[I_X] + (size_t)(t0 + a) * DM + j * 256 + lane * 4);
#pragma unroll
        for (int a = 0; a < 4; ++a) {
            float ss = 0.f;
#pragma unroll
            for (int j = 0; j < 4; ++j) ss += v[a][j][0] * v[a][j][0] + v[a][j][1] * v[a][j][1] + v[a][j][2] * v[a][j][2] + v[a][j][3] * v[a][j][3];
            ss = wave_sum(ss, lane);
            const float rstd = rsqrtf(ss * (1.0f / 1024.0f) + RMS_EPS);
            unsigned char* orow = ws + WS_U + (size_t)(t0 + a) * DM;
#pragma unroll
            for (int j = 0; j < 4; ++j) {
                int w8 = 0;
                w8 = __builtin_amdgcn_cvt_pk_fp8_f32(clamp448_early(v[a][j][0] * rstd * gg[j][0]), clamp448_early(v[a][j][1] * rstd * gg[j][1]), w8, false);
                w8 = __builtin_amdgcn_cvt_pk_fp8_f32(clamp448_early(v[a][j][2] * rstd * gg[j][2]), clamp448_early(v[a][j][3] * rstd * gg[j][3]), w8, true);
                *(int*)(orow + j * 256 + lane * 4) = w8;
            }
        }
    }
}

#define LAS __attribute__((address_space(3)))
namespace g8 {
constexpr int HTB = 128 * 64 * 2;
constexpr int STAGE_BYTES = 8 * HTB;
__device__ __forceinline__ int lds_byte(int r, int c) { const int st = (r >> 4) * 2 + (c >> 5), rr = r & 15, cc = c & 31, ob = rr * 64 + cc * 2; return st * 1024 + (ob ^ (((ob >> 9) & 1) << 5)); }
__device__ __forceinline__ void stage_rc(int b, int& R, int& C) { const int st = b / 1024, sb = b % 1024, swz = sb ^ (((sb >> 9) & 1) << 5); R = (st >> 1) * 16 + swz / 64; C = (st & 1) * 32 + (swz % 64) / 2; }
__device__ __forceinline__ int perm32(int rho) { const int n = rho >> 4, i = rho & 15; return 8 * (i >> 2) + 4 * n + (i & 3); }

struct Unit { const char* Bb; int a0; int orow; int ocol; int e; };

typedef f32x4 Acc[2][2][4][2];

typedef int v8i __attribute__((ext_vector_type(8)));
typedef int v4i __attribute__((ext_vector_type(4)));
template <class Sched, class Epi, int FP8 = 0>
__device__ __forceinline__ void gemm_phase(LAS unsigned char* lds, const char* Abase, int ldb_bytes, int nt, const Sched& S, const Epi& E, int wscale = 0x7F7F7F7F) {
    const int tid = tid_opaque(), wid = __builtin_amdgcn_readfirstlane(tid >> 6), lane = tid & 63, wr = wid >> 2, wc = wid & 3, fr = lane & 15, fq = lane >> 4;
    int R[2], C[2]; unsigned voffB[2];
#pragma unroll
    for (int i = 0; i < 2; ++i) { stage_rc(tid * 16 + i * 8192, R[i], C[i]); const int Rb = (R[i] & ~31) + perm32(R[i] & 31); voffB[i] = (unsigned)(Rb * ldb_bytes + C[i] * 2); }
    const unsigned ldsw = (unsigned)wid * 1024u;
    const int aoffl = lds_byte(wr * 64 + fr, fq * 8), boffl = lds_byte(wc * 32 + fr, fq * 8);
#define G8_SA(b, h) (((b) * 2 + (h)) * g8::HTB)
#define G8_SB(b, h) ((4 + (b) * 2 + (h)) * g8::HTB)
#define G8_STG_A(bufoff, kptr, h) do { _Pragma("unroll") for (int _i = 0; _i < 2; ++_i) \
        __builtin_amdgcn_global_load_lds((const unsigned*)((const char*)(kptr) + aoff[h][_i]), (LAS unsigned*)(lds + (bufoff) + ldsw + _i * 8192), 16, 0, 0); } while (0)
#define G8_STG_B(bufoff, bptr) do { _Pragma("unroll") for (int _i = 0; _i < 2; ++_i) \
        __builtin_amdgcn_global_load_lds((const unsigned*)((const char*)(bptr) + voffB[_i]), (LAS unsigned*)(lds + (bufoff) + ldsw + _i * 8192), 16, 0, 0); } while (0)
#define G8_LDA(dst, b, h) do { _Pragma("unroll") for (int m = 0; m < 4; ++m) _Pragma("unroll") for (int k = 0; k < 2; ++k) dst[m][k] = *(const LAS bf16x8*)(lds + G8_SA(b, h) + aoffl + m * 2048 + k * 1024); } while (0)
#define G8_LDB(dst, b, h) do { _Pragma("unroll") for (int n = 0; n < 2; ++n) _Pragma("unroll") for (int k = 0; k < 2; ++k) dst[n][k] = *(const LAS bf16x8*)(lds + G8_SB(b, h) + boffl + n * 2048 + k * 1024); } while (0)
#define G8_CAT(x) __builtin_shufflevector(__builtin_bit_cast(g8::v4i, x[0]), __builtin_bit_cast(g8::v4i, x[1]), 0, 1, 2, 3, 4, 5, 6, 7)
#define G8_MMA(ai, bj, At, Bt) do { __builtin_amdgcn_s_setprio(1); _Pragma("unroll") for (int m = 0; m < 4; ++m) _Pragma("unroll") for (int n = 0; n < 2; ++n) { \
        if (FP8) acc[ai][bj][m][n] = __builtin_amdgcn_mfma_scale_f32_16x16x128_f8f6f4(G8_CAT(Bt[n]), G8_CAT(At[m]), acc[ai][bj][m][n], 0, 0, 0, wscale, 0, 0x7F7F7F7F); \
        else { _Pragma("unroll") for (int k = 0; k < 2; ++k) acc[ai][bj][m][n] = __builtin_amdgcn_mfma_f32_16x16x32_bf16(Bt[n][k], At[m][k], acc[ai][bj][m][n], 0, 0, 0); } } \
        __builtin_amdgcn_s_setprio(0); } while (0)
#define G8_WAIT_V(n) asm volatile("s_waitcnt vmcnt(" #n ")" ::: "memory")
#define G8_WAIT_L(n) asm volatile("s_waitcnt lgkmcnt(" #n ")" ::: "memory")
#define G8_BAR __builtin_amdgcn_s_barrier()
#define G8_SCHED __builtin_amdgcn_sched_barrier(0)
    Unit cur, nxt; int ui = 0;
    if (!S.next(0, cur)) return;
    Acc acc;
    f32x4 ib[4];
    if constexpr (Epi::HAS_INIT) E.load_init(cur, wc, fq, ib);
#pragma unroll
    for (int a = 0; a < 2; ++a)
#pragma unroll
        for (int b = 0; b < 2; ++b)
#pragma unroll
            for (int m = 0; m < 4; ++m)
#pragma unroll
                for (int n = 0; n < 2; ++n) { if constexpr (Epi::HAS_INIT) acc[a][b][m][n] = ib[2 * b + n]; else acc[a][b][m][n] = (f32x4){0.f, 0.f, 0.f, 0.f}; }
    if constexpr (Epi::HAS_TILE_INIT) E.init_tile(acc, cur, wr, wc, fr, fq);
    bf16x8 At[4][2], B0[2][2], B1[2][2];
    unsigned aoff[2][2];
    S.aoffs(cur, R, C, aoff);
    const char* cB = cur.Bb; const int chB = S.hB();
#define G8_KOFF(u, s) ((size_t)(((s) & (nt - 1)) * 128))
    { const size_t k0 = G8_KOFF(cur, 0), k1 = G8_KOFF(cur, 1);
    G8_STG_B(G8_SB(0, 0), cB + k0); G8_STG_B(G8_SB(0, 1), cB + chB + k0); G8_STG_A(G8_SA(0, 0), Abase + k0, 0); G8_STG_A(G8_SA(0, 1), Abase + k0, 1);
    if (wr == 1) G8_BAR;
    G8_WAIT_V(2); G8_BAR;
    G8_STG_B(G8_SB(1, 0), cB + k1); G8_STG_A(G8_SA(1, 0), Abase + k1, 0); G8_STG_B(G8_SB(1, 1), cB + chB + k1);
    G8_WAIT_V(6); G8_BAR; }
    for (;;) {
        const bool has_next = S.next(ui + 1, nxt);
        const char* nB = has_next ? nxt.Bb : cB;
#pragma unroll 1
        for (int t = 0; t < nt; t += 2) {
            const bool last = (t == nt - 2);
            const Unit& nu = has_next ? nxt : cur;
            const size_t o1 = G8_KOFF(cur, t + 1), o2 = last ? G8_KOFF(nu, 0) : G8_KOFF(cur, t + 2), o3 = last ? G8_KOFF(nu, 1) : G8_KOFF(cur, t + 3);
            const char* a1 = Abase + o1;
            const char* a2 = Abase + o2; const char* b2 = (last ? nB : cB) + o2; const int hb2 = chB;
            const char* a3 = Abase + o3; const char* b3 = (last ? nB : cB) + o3;
            G8_LDB(B0, 0, 0); G8_LDB(B1, 0, 1); G8_SCHED; G8_LDA(At, 0, 0); G8_STG_A(G8_SA(1, 1), a1, 1);
            if (last && has_next) S.aoffs(nxt, R, C, aoff);
            G8_WAIT_V(8); G8_WAIT_L(0); G8_BAR; G8_MMA(0, 0, At, B0); G8_MMA(0, 1, At, B1); G8_BAR; G8_SCHED;
            G8_LDA(At, 0, 1); G8_STG_B(G8_SB(0, 0), b2); G8_STG_B(G8_SB(0, 1), b2 + hb2); G8_STG_A(G8_SA(0, 0), a2, 0);
            G8_WAIT_V(8); G8_WAIT_L(0); G8_BAR; G8_MMA(1, 0, At, B0); G8_MMA(1, 1, At, B1); G8_BAR; G8_SCHED;
            G8_LDB(B0, 1, 0); G8_LDB(B1, 1, 1); G8_SCHED; G8_LDA(At, 1, 0); G8_STG_A(G8_SA(0, 1), a2, 1);
            G8_WAIT_V(8); G8_WAIT_L(0); G8_BAR; G8_MMA(0, 0, At, B0); G8_MMA(0, 1, At, B1); G8_BAR; G8_SCHED;
            G8_LDA(At, 1, 1); G8_STG_B(G8_SB(1, 0), b3); G8_STG_B(G8_SB(1, 1), b3 + hb2); G8_STG_A(G8_SA(1, 0), a3, 0);
            G8_WAIT_V(8); G8_WAIT_L(0); G8_BAR; G8_MMA(1, 0, At, B0); G8_MMA(1, 1, At, B1); G8_BAR; G8_SCHED;
        }
        if (wr == 0) G8_BAR;
        if constexpr (Epi::HAS_INIT) { if (has_next) E.load_init(nxt, wc, fq, ib); }
        E(acc, cur, wr, wc, fr, fq);
        if (!has_next) break;
#pragma unroll
        for (int a = 0; a < 2; ++a)
#pragma unroll
            for (int b = 0; b < 2; ++b)
#pragma unroll
                for (int m = 0; m < 4; ++m)
#pragma unroll
                    for (int n = 0; n < 2; ++n) { if constexpr (Epi::HAS_INIT) acc[a][b][m][n] = ib[2 * b + n]; else acc[a][b][m][n] = (f32x4){0.f, 0.f, 0.f, 0.f}; }
        if constexpr (Epi::HAS_TILE_INIT) E.init_tile(acc, nxt, wr, wc, fr, fq);
        cur = nxt; cB = nB; ++ui;
        if (wr == 1) G8_BAR;
    }
    G8_WAIT_V(0);
    G8_BAR;
#undef G8_SA
#undef G8_SB
#undef G8_STG_A
#undef G8_STG_B
#undef G8_LDA
#undef G8_LDB
#undef G8_MMA
#undef G8_KOFF
#undef G8_CAT
#undef G8_WAIT_V
#undef G8_WAIT_L
#undef G8_BAR
#undef G8_SCHED
}

struct DenseSched {
    int nM, nN, nwg, G, c, abytes; const char* Bt; int bbytes; int acolB;
    __device__ __forceinline__ int hB() const { return 128 * bbytes; }
    __device__ __forceinline__ void init(int M, int N, int G_, int c_, int abytes_, const void* Bt_, int bbytes_, int acolB_) { nM = M / 256; nN = N / 256; nwg = nM * nN; G = G_; c = c_; abytes = abytes_; Bt = (const char*)Bt_; bbytes = bbytes_; acolB = acolB_; }
    __device__ __forceinline__ bool next(int i, Unit& u) const {
        const long L = (long)i * G + c; if (L >= nwg) return false;
        int wgid = (int)L; { const int q = nwg / 8, r = nwg % 8, xcd = wgid % 8, off = wgid / 8; wgid = (xcd < r ? xcd * (q + 1) : r * (q + 1) + (xcd - r) * q) + off; }
        const int nig = 8 * nN, gid = wgid / nig, fm = gid * 8, gsz = (nM - fm) < 8 ? (nM - fm) : 8;
        const int pm = fm + ((wgid % nig) % gsz), pn = (wgid % nig) / gsz;
        u.a0 = pm * 256; u.orow = pm * 256; u.ocol = pn * 256; u.e = 0; u.Bb = Bt + (size_t)pn * 256 * bbytes; return true;
    }
    __device__ __forceinline__ void aoffs(const Unit& u, const int (&R)[2], const int (&C)[2], unsigned (&aoff)[2][2]) const {
#pragma unroll
        for (int h = 0; h < 2; ++h)
#pragma unroll
            for (int i = 0; i < 2; ++i) aoff[h][i] = (unsigned)((u.a0 + h * 128 + R[i]) * abytes + acolB + C[i] * 2);
    }
};

__device__ __forceinline__ u32x4 pack8(const f32x4& a, const f32x4& b) { u32x4 w; w.x = pk2(a[0], a[1]); w.y = pk2(a[2], a[3]); w.z = pk2(b[0], b[1]); w.w = pk2(b[2], b[3]); return w; }
__device__ __forceinline__ float fast_rcp(float x) { return __builtin_amdgcn_rcpf(x); }
__device__ __forceinline__ float clamp448(float x) { return __builtin_fminf(__builtin_fmaxf(x, -448.0f), 448.0f); }
__device__ __forceinline__ u32x2 pack8_fp8(const f32x4& a, const f32x4& b) {
    int w0 = 0, w1 = 0;
    w0 = __builtin_amdgcn_cvt_pk_fp8_f32(clamp448(a[0]), clamp448(a[1]), w0, false); w0 = __builtin_amdgcn_cvt_pk_fp8_f32(clamp448(a[2]), clamp448(a[3]), w0, true);
    w1 = __builtin_amdgcn_cvt_pk_fp8_f32(clamp448(b[0]), clamp448(b[1]), w1, false); w1 = __builtin_amdgcn_cvt_pk_fp8_f32(clamp448(b[2]), clamp448(b[3]), w1, true);
    u32x2 r; r.x = (unsigned)w0; r.y = (unsigned)w1; return r;
}
__device__ __forceinline__ float clamp448m(float x) { return __builtin_amdgcn_fmed3f(x, -448.0f, 448.0f); }
__device__ __forceinline__ u32x2 pack8_fp8_m3(const f32x4& a, const f32x4& b) {
    int w0 = 0, w1 = 0;
    w0 = __builtin_amdgcn_cvt_pk_fp8_f32(clamp448m(a[0]), clamp448m(a[1]), w0, false); w0 = __builtin_amdgcn_cvt_pk_fp8_f32(clamp448m(a[2]), clamp448m(a[3]), w0, true);
    w1 = __builtin_amdgcn_cvt_pk_fp8_f32(clamp448m(b[0]), clamp448m(b[1]), w1, false); w1 = __builtin_amdgcn_cvt_pk_fp8_f32(clamp448m(b[2]), clamp448m(b[3]), w1, true);
    u32x2 r; r.x = (unsigned)w0; r.y = (unsigned)w1; return r;
}
__device__ __forceinline__ u32x2 pack8_fp8_noclamp(const f32x4& a, const f32x4& b) {
    int w0 = 0, w1 = 0;
    w0 = __builtin_amdgcn_cvt_pk_fp8_f32(a[0], a[1], w0, false); w0 = __builtin_amdgcn_cvt_pk_fp8_f32(a[2], a[3], w0, true);
    w1 = __builtin_amdgcn_cvt_pk_fp8_f32(b[0], b[1], w1, false); w1 = __builtin_amdgcn_cvt_pk_fp8_f32(b[2], b[3], w1, true);
    u32x2 r; r.x = (unsigned)w0; r.y = (unsigned)w1; return r;
}
__device__ __forceinline__ float gelu_fast(float x) { const float t = x * __builtin_fmaf(x * x, -0.10294324f, -2.3022082f); return x * fast_rcp(1.0f + __builtin_amdgcn_exp2f(t)); }
#define G8_FOR_ROWS for (int ai = 0; ai < 2; ++ai) for (int m = 0; m < 4; ++m)
__device__ __forceinline__ u32x4 rowmajor16(const u32x4& w, int srcb) {
    u32x4 r; r.x = (unsigned)__builtin_amdgcn_ds_bpermute(srcb, (int)w.x); r.y = (unsigned)__builtin_amdgcn_ds_bpermute(srcb, (int)w.y);
    r.z = (unsigned)__builtin_amdgcn_ds_bpermute(srcb, (int)w.z); r.w = (unsigned)__builtin_amdgcn_ds_bpermute(srcb, (int)w.w); return r;
}

template <int MODE> struct EpiB {
    bf16_t* o0; bf16_t* o1; bf16_t* o2; const float* sc; float qs; int ld; int coff;
    static constexpr bool HAS_INIT = (MODE == 4), HAS_TILE_INIT = false;
    __device__ __forceinline__ void load_init(const Unit& u, int wc, int fq, f32x4 (&b)[4]) const {
        const float* bp = sc + u.e * 1024 + u.ocol + coff + wc * 32 + 8 * fq;
#pragma unroll
        for (int bj = 0; bj < 2; ++bj) { b[2 * bj] = *(const f32x4*)(bp + bj * 128) * 16.0f; b[2 * bj + 1] = *(const f32x4*)(bp + bj * 128 + 4) * 16.0f; }
    }
    __device__ __forceinline__ void operator()(const Acc& acc, const Unit& u, int wr, int wc, int fr, int fq) const {
        if constexpr (MODE == 4) {
            int ln = fr + 16 * fq; asm volatile("" : "+v"(ln));
            const int fqv = ln >> 4; const bool odd = (fqv & 1) != 0; const int partner = (ln ^ 16) << 2;
            unsigned char* yb = (unsigned char*)o0; const int c16 = u.ocol + coff + wc * 32 + 8 * (fqv & ~1) + (odd ? 128 : 0);
#pragma unroll
            G8_FOR_ROWS {
                const u32x2 w0 = pack8_fp8_m3(acc[ai][0][m][0], acc[ai][0][m][1]), w1 = pack8_fp8_m3(acc[ai][1][m][0], acc[ai][1][m][1]);
                const u32x2 snd = odd ? w0 : w1; u32x2 rcv;
                rcv.x = (unsigned)__builtin_amdgcn_ds_bpermute(partner, (int)snd.x); rcv.y = (unsigned)__builtin_amdgcn_ds_bpermute(partner, (int)snd.y);
                u32x4 o4; o4.x = odd ? rcv.x : w0.x; o4.y = odd ? rcv.y : w0.y; o4.z = odd ? w1.x : rcv.x; o4.w = odd ? w1.y : rcv.y;
                *(u32x4*)(yb + (size_t)(u.orow + ai * 128 + wr * 64 + m * 16 + (ln & 15)) * ld + c16) = o4;
            }
            return;
        }
        bf16_t* base = o0; int col = u.ocol; float mul = 1.0f; bool gel = false;
        if (MODE == 1) { if (col < 1024) gel = true; else { base = o1; col -= 1024; } }
        if (MODE == 2) { if (col < 1024) mul = qs; else if (col < 2048) { base = o1; col -= 1024; } else { base = o2; col -= 2048; } }
        const int ln = fr + 16 * fq, fr2 = ln >> 2, fq2 = ln & 3, srcb = (fr2 + 16 * fq2) << 2;
        const int col2 = col + coff + wc * 32 + 8 * fq2;
        col += coff + wc * 32 + 8 * fq;
        f32x4 s0[2], s1[2];
        if (MODE == 3) {
#pragma unroll
            for (int bj = 0; bj < 2; ++bj) { s0[bj] = *(const f32x4*)(sc + col + bj * 128); s1[bj] = *(const f32x4*)(sc + col + bj * 128 + 4); }
        }
#pragma unroll
        G8_FOR_ROWS {
            bf16_t* rowp = base + (size_t)(u.orow + ai * 128 + wr * 64 + m * 16 + fr2) * ld + col2;
#pragma unroll
            for (int bj = 0; bj < 2; ++bj) {
                f32x4 v0 = acc[ai][bj][m][0], v1 = acc[ai][bj][m][1];
                if (MODE == 1) { if (gel) {
#pragma unroll
                    for (int j = 0; j < 4; ++j) { v0[j] = gelu_fast(v0[j]); v1[j] = gelu_fast(v1[j]); } } }
                if (MODE == 2) { v0 = v0 * mul; v1 = v1 * mul; }
                if (MODE == 3) { v0 = v0 * s0[bj]; v1 = v1 * s1[bj]; }
                *(u32x4*)(rowp + bj * 128) = rowmajor16(pack8(v0, v1), srcb);
            }
        }
    }
};
struct EpiRes {
    const float* hin32; const bf16_t* hin16; bf16_t* hout;
    static constexpr bool HAS_INIT = false, HAS_TILE_INIT = true;
    __device__ __forceinline__ void init_tile(Acc& acc, const Unit& u, int wr, int wc, int fr, int fq) const {
        const int col = u.ocol + wc * 32 + 8 * fq;
#pragma unroll
        G8_FOR_ROWS {
            const size_t ro = (size_t)(u.orow + ai * 128 + wr * 64 + m * 16 + fr) * DM + col;
#pragma unroll
            for (int bj = 0; bj < 2; ++bj) {
                f32x4 h0, h1;
                if (hin32) { h0 = *(const f32x4*)(hin32 + ro + bj * 128); h1 = *(const f32x4*)(hin32 + ro + bj * 128 + 4); }
                else { const u32x4 w = *(const u32x4*)(hin16 + ro + bj * 128);
                    h0[0] = __uint_as_float(w.x << 16); h0[1] = __uint_as_float(w.x & 0xffff0000u); h0[2] = __uint_as_float(w.y << 16); h0[3] = __uint_as_float(w.y & 0xffff0000u);
                    h1[0] = __uint_as_float(w.z << 16); h1[1] = __uint_as_float(w.z & 0xffff0000u); h1[2] = __uint_as_float(w.w << 16); h1[3] = __uint_as_float(w.w & 0xffff0000u); }
                acc[ai][bj][m][0] = h0; acc[ai][bj][m][1] = h1;
            }
        }
    }
    __device__ __forceinline__ void operator()(const Acc& acc, const Unit& u, int wr, int wc, int fr, int fq) const {
        const int ln = fr + 16 * fq, fr2 = ln >> 2, fq2 = ln & 3, srcb = (fr2 + 16 * fq2) << 2;
        const int col = u.ocol + wc * 32 + 8 * fq2;
#pragma unroll
        G8_FOR_ROWS {
            const size_t ro = (size_t)(u.orow + ai * 128 + wr * 64 + m * 16 + fr2) * DM + col;
#pragma unroll
            for (int bj = 0; bj < 2; ++bj) *(u32x4*)(hout + ro + bj * 128) = rowmajor16(pack8(acc[ai][bj][m][0], acc[ai][bj][m][1]), srcb);
        }
    }
};

struct PoolGrpSched {
    int G, c; const char* Wg;
    __device__ __forceinline__ int hB() const { return 128 * 256 * 2; }
    __device__ __forceinline__ bool next(int i, Unit& u) const {
        const int uu = i * G + c; if (uu >= 256) return false;
        const int L = (uu & 7) * 32 + (uu >> 3);
        const int g = L & 3, pm = L >> 2;
        u.a0 = pm * 256; u.orow = pm * 256; u.ocol = g * 256; u.e = g; u.Bb = Wg + (size_t)g * 256 * 256 * 2; return true;
    }
    __device__ __forceinline__ void aoffs(const Unit& u, const int (&R)[2], const int (&C)[2], unsigned (&aoff)[2][2]) const {
#pragma unroll
        for (int h = 0; h < 2; ++h)
#pragma unroll
            for (int i = 0; i < 2; ++i) aoff[h][i] = (unsigned)((u.a0 + h * 128 + R[i]) * DM + u.e * 256 + C[i]) * 2u;
    }
};

constexpr int MOE_TAB_PS = 0, MOE_TAB_CUM = 64, MOE_TAB_UL = 128, MOE_TAB_CNT = 160, MOE_TAB_ROW = 256, MOE_MAXU = 10;
template <int G1> struct MoeSched {
    __device__ __forceinline__ int hB() const { return G1 ? 1024 * 1024 : 128 * 1024; }
    LAS const int* tab; int total, G, c; const char* W; bool xl;
    __device__ __forceinline__ bool search(int i, int& e, int& rt, int& ct) const {
        int wgid;
        if (xl) {
            const int Wd = G1 ? 8 : 4, NR = total / Wd, x = c & 7;
            const int R0 = (x * NR) >> 3, R1 = ((x + 1) * NR) >> 3, off = i * (G >> 3) + (c >> 3);
            if (off >= (R1 - R0) * Wd) return false;
            wgid = R0 * Wd + (G1 ? off : (R1 - R0) * Wd - 1 - off);
        } else {
            const int L = i * G + c; if (L >= total) return false;
            const int q = total / 8, r = total % 8, xcd = L % 8, off = L / 8;
            wgid = (xcd < r ? xcd * (q + 1) : r * (q + 1) + (xcd - r) * q) + off;
        }
        e = 0;
#pragma unroll 1
        for (int j = 1; j < NE; ++j) if (tab[MOE_TAB_CUM + j] <= wgid) e = j;
        const int rem = wgid - tab[MOE_TAB_CUM + e];
        if (G1) { rt = rem >> 3; ct = rem & 7; } else { rt = rem >> 2; ct = rem & 3; }
        return true;
    }
    __device__ __forceinline__ bool decode(int i, int& e, int& rt, int& ct) const {
        if (i >= MOE_MAXU) return false;
        const int v = tab[MOE_TAB_UL + i]; if (v < 0) return false;
        e = v >> 16; rt = (v >> 8) & 255; ct = v & 255; return true;
    }
    __device__ __forceinline__ bool next(int i, Unit& u) const {
        int e, rt, ct; if (!decode(i, e, rt, ct)) return false;
        u.e = e; u.orow = tab[MOE_TAB_PS + e] + rt * 256;
        if (G1) { u.ocol = ct * 128; u.Bb = W + ((size_t)e * 2048 + ct * 128) * 1024; u.a0 = i; }
        else    { u.ocol = ct * 256; u.Bb = W + ((size_t)e * 1024 + ct * 256) * 1024; u.a0 = u.orow; }
        return true;
    }
    __device__ __forceinline__ void aoffs(const Unit& u, const int (&R)[2], const int (&C)[2], unsigned (&aoff)[2][2]) const {
#pragma unroll
        for (int h = 0; h < 2; ++h)
#pragma unroll
            for (int i = 0; i < 2; ++i) {
                const int row = G1 ? tab[MOE_TAB_ROW + u.a0 * 256 + h * 128 + R[i]] : (u.a0 + h * 128 + R[i]);
                aoff[h][i] = (unsigned)(row * DM + C[i] * 2);
            }
    }
};
struct EpiG1 {
    unsigned char* act; const float* bgu;
    static constexpr bool HAS_INIT = true, HAS_TILE_INIT = false;
    __device__ __forceinline__ void load_init(const Unit& u, int wc, int fq, f32x4 (&b)[4]) const {
        const float* bp = bgu + (size_t)u.e * 2048 + u.ocol + wc * 32 + 8 * fq;
        b[0] = *(const f32x4*)bp * SWI_C; b[1] = *(const f32x4*)(bp + 4) * SWI_C; b[2] = *(const f32x4*)(bp + 1024) + 1.0f; b[3] = *(const f32x4*)(bp + 1028) + 1.0f;
    }
    __device__ __forceinline__ void operator()(const Acc& acc, const Unit& u, int wr, int wc, int fr, int fq) const {
        const int col = u.ocol + wc * 32 + 8 * fq;
#pragma unroll
        G8_FOR_ROWS {
            f32x4 o[2];
#pragma unroll
            for (int n = 0; n < 2; ++n) {
                const f32x4 g = acc[ai][0][m][n], up = acc[ai][1][m][n];
#pragma unroll
                for (int jp = 0; jp < 2; ++jp) {
                    f32x2_t gt2, uu2, d2, r2;
#pragma unroll
                    for (int q = 0; q < 2; ++q) {
                        float gt; asm("v_min_f32_e32 %0, %1, %2" : "=v"(gt) : "s"(7.0f * SWI_C), "v"(g[2 * jp + q]));
                        gt2[q] = gt; uu2[q] = __builtin_amdgcn_fmed3f(up[2 * jp + q], -6.0f, 8.0f); d2[q] = __builtin_amdgcn_exp2f(-gt);
                    }
                    d2 = d2 + 1.0f;
                    r2[0] = fast_rcp(d2[0]); r2[1] = fast_rcp(d2[1]);
                    const f32x2_t o2 = (uu2 * gt2) * r2;
                    o[n][2 * jp] = o2[0]; o[n][2 * jp + 1] = o2[1];
                }
            }
            *(u32x2*)(act + (size_t)(u.orow + ai * 128 + wr * 64 + m * 16 + fr) * DM + col) = pack8_fp8_noclamp(o[0], o[1]);
        }
    }
};
}

constexpr int CQ_IDLE_MASK = 3;
constexpr unsigned CQ_TICKS_PER_UNIT = 2400u;
constexpr int CQ_PER_LAYER = 6144, CQ_TOTAL = 4 * CQ_PER_LAYER, CW_QHEAD = 8448;
struct CqJob { const float* src; unsigned char* dst; int N, k0, n0; float sc; };
__device__ __forceinline__ void convq_decode(const Params& p, int q, CqJob& J) {
    const int l = q / CQ_PER_LAYER; int j = q - l * CQ_PER_LAYER;
    if (j < 4096) { const int m = j >> 7, r = j & 127; J.N = 2048; J.k0 = (r >> 3) * 64; J.n0 = (r & 7) * 256;
        J.src = p.in[I_MOE_WGU] + (size_t)(l * NE + m) * 1024 * 2048; J.dst = (p.ws + WT_GU) + (size_t)(l * NE + m) * 2048 * 1024; J.sc = (J.n0 < 1024) ? 32.0f * SWI_C : 32.0f; }
    else { j -= 4096; const int m = j >> 6, r = j & 63; J.N = 1024; J.k0 = (r >> 2) * 64; J.n0 = (r & 3) * 256;
        J.src = p.in[I_MOE_WDN] + (size_t)(l * NE + m) * 1024 * 1024; J.dst = (p.ws + WT_DN) + (size_t)(l * NE + m) * 1024 * 1024; J.sc = 64.0f / SWI_C; }
}
__device__ __forceinline__ void conv_range(const Params& p, unsigned char* smem, int first, int last, int bid, int nblk) {
    const int tidx = tid_opaque(), lane = tidx & 63, kg = tidx >> 6;
    int q = first + bid;
    __syncthreads();
    if (q >= last) return;
    CqJob J, Jn; f32x4 v[8], vn[8];
    convq_decode(p, q, J);
#pragma unroll
    for (int i = 0; i < 8; ++i) v[i] = __builtin_nontemporal_load((const f32x4*)(J.src + (size_t)(J.k0 + kg * 8 + i) * J.N + J.n0 + lane * 4));
#pragma unroll 1
    for (;;) {
        const int qn = q + nblk; const bool hn = qn < last;
        if (hn) {
            convq_decode(p, qn, Jn);
#pragma unroll
            for (int i = 0; i < 8; ++i) vn[i] = __builtin_nontemporal_load((const f32x4*)(Jn.src + (size_t)(Jn.k0 + kg * 8 + i) * Jn.N + Jn.n0 + lane * 4));
        }
#pragma unroll
        for (int i = 0; i < 4; ++i) {
            f32x4 a, b; a[0] = v[0][i] * J.sc; a[1] = v[1][i] * J.sc; a[2] = v[2][i] * J.sc; a[3] = v[3][i] * J.sc; b[0] = v[4][i] * J.sc; b[1] = v[5][i] * J.sc; b[2] = v[6][i] * J.sc; b[3] = v[7][i] * J.sc;
            *(u32x2*)(smem + (lane * 4 + i) * 72 + kg * 8) = g8::pack8_fp8(a, b);
        }
        __syncthreads();
#pragma unroll
        for (int q4 = 0; q4 < 2; ++q4) {
            const int nn = q4 * 128 + (tidx >> 2), ch = tidx & 3;
            u32x4 w; const u32x2 w0 = *(const u32x2*)(smem + nn * 72 + ch * 16), w1 = *(const u32x2*)(smem + nn * 72 + ch * 16 + 8); w.x = w0.x; w.y = w0.y; w.z = w1.x; w.w = w1.y;
            *(u32x4*)(J.dst + (size_t)(J.n0 + nn) * 1024 + J.k0 + ch * 16) = w;
        }
        __syncthreads();
        if (!hn) break;
        q = qn; J = Jn;
#pragma unroll
        for (int i = 0; i < 8; ++i) v[i] = vn[i];
    }
}

constexpr int LDS_MISC_OFF = 64;
template <int G1>
__device__ __forceinline__ void phase_moe_gemm_fast(const Params& p, int layer, unsigned char* smem, int bid, int nblk, bool xl) {
    const int tidx = tid_opaque();
    unsigned char* ws = p.ws;
    LAS int* tab = (LAS int*)(smem + g8::STAGE_BYTES + LDS_MISC_OFF);
    const int* cnt = (const int*)(ws + WS_CTL) + CW_CNT + layer * NE;
    if (tidx < 32) {
        if constexpr (G1 != 0) {
            const int c = cnt[tidx], tiles = (c + 255) >> 8; int incl = tiles;
#pragma unroll
            for (int off = 1; off < 32; off <<= 1) { const int v = __builtin_amdgcn_ds_bpermute((tidx >= off ? tidx - off : tidx) << 2, incl); if (tidx >= off) incl += v; }
            const int excl = incl - tiles;
            tab[g8::MOE_TAB_PS + tidx] = excl << 8; tab[g8::MOE_TAB_CUM + tidx] = excl * 8; tab[g8::MOE_TAB_CNT + tidx] = c;
            if (tidx == 31) { tab[g8::MOE_TAB_PS + NE] = incl << 8; tab[g8::MOE_TAB_CUM + NE] = incl * 8; }
        } else {
            tab[g8::MOE_TAB_CUM + tidx] = (tab[g8::MOE_TAB_PS + tidx] >> 8) * 4;
            if (tidx == 31) tab[g8::MOE_TAB_CUM + NE] = (tab[g8::MOE_TAB_PS + NE] >> 8) * 4;
        }
    }
    __syncthreads();
    g8::MoeSched<G1> S; S.tab = (LAS const int*)tab; S.total = tab[g8::MOE_TAB_CUM + NE]; S.G = nblk; S.c = bid; S.xl = xl;
    S.W = (const char*)(ws + (G1 ? WT_GU : WT_DN)) + (size_t)layer * NE * (G1 ? 2048 : 1024) * 1024;
    if (tidx < g8::MOE_MAXU) { int e, rt, ct; tab[g8::MOE_TAB_UL + tidx] = S.search(tidx, e, rt, ct) ? ((e << 16) | (rt << 8) | ct) : -1; }
    __syncthreads();
    if constexpr (G1 != 0) {
        const int* list = (const int*)(ws + WS_LIST);
#pragma unroll
        for (int j = 0; j < (g8::MOE_MAXU * 256) / 512; ++j) {
            const int idx = tidx + j * 512, i = idx >> 8, r = idx & 255;
            int e, rt, ct;
            if (S.decode(i, e, rt, ct)) { const int ce = tab[g8::MOE_TAB_CNT + e]; int id = rt * 256 + r; id = id < ce ? id : ce - 1; tab[g8::MOE_TAB_ROW + i * 256 + r] = list[e * ECAP + id]; }
        }
        __syncthreads();
        g8::gemm_phase<g8::MoeSched<1>, g8::EpiG1, 1>((LAS unsigned char*)smem, (const char*)(ws + WS_U8), DM, DM / 128, S, g8::EpiG1{(unsigned char*)(ws + WS_ACT), p.in[I_MOE_BGU] + (size_t)layer * NE * 2048}, 0x7A7A7A7A);
    } else {
        g8::gemm_phase<g8::MoeSched<0>, g8::EpiB<4>, 1>((LAS unsigned char*)smem, (const char*)(ws + WS_ACT), DM, DM / 128, S, g8::EpiB<4>{(bf16_t*)(ws + WS_YS), nullptr, nullptr, p.in[I_MOE_BDN] + (size_t)layer * NE * 1024, 0.f, DM, 0}, 0x7D7D7D7D);
    }
    if (layer < 3) {
        int mine = 0;
#pragma unroll
        for (int i = 0; i < g8::MOE_MAXU; ++i) mine += (tab[g8::MOE_TAB_UL + i] >= 0) ? 1 : 0;
        mine = __builtin_amdgcn_readfirstlane(mine);
        int maxu = (S.total + nblk - 1) / nblk;
        if (xl) { const int Wd = G1 ? 8 : 4, NR = S.total / Wd, x = bid & 7; maxu = ((((x + 1) * NR) >> 3) - ((x * NR) >> 3)) * Wd; maxu = (maxu + (nblk >> 3) - 1) / (nblk >> 3); }
        const int target = layer + 1, tb = (target % 3 == 0) ? 2048 : 0;
        int* qh = (int*)(ws + WS_CTL) + CW_QHEAD + target;
        LAS int* slot = (LAS int*)(smem + g8::STAGE_BYTES + 48);
#pragma unroll 1
        for (int k = 0; k < (maxu - mine) * 3; ++k) {
            __syncthreads();
            if (tidx == 0) *slot = atomicAdd(qh, 2);
            __syncthreads();
            const int u = __builtin_amdgcn_readfirstlane(*slot) + tb;
            if (u >= CQ_PER_LAYER) break;
            conv_range(p, smem, target * CQ_PER_LAYER + u, target * CQ_PER_LAYER + (u + 2 < CQ_PER_LAYER ? u + 2 : CQ_PER_LAYER), 0, 1);
        }
    }
}
__device__ __forceinline__ void phase_lru_mid(const Params& p, int slot, unsigned char* smem, int bid, int nblk) {
    const int tid = tid_opaque(), wid = __builtin_amdgcn_readfirstlane(tid >> 6), lane = tid & 63, r32 = lane & 31, hi = lane >> 5;
    unsigned char* ws = p.ws;
    const bf16_t* XBP = (const bf16_t*)(ws + WS_B1); const bf16_t* GG = (const bf16_t*)(ws + WS_B0); bf16_t* Y = (bf16_t*)(ws + WS_B3);
    LAS unsigned char* Al = (LAS unsigned char*)smem;
    LAS float* wAB = (LAS float*)(smem + 69632);
    LAS float* cwl = (LAS float*)(smem + 69632 + 2048);
    LAS unsigned char* wfl = (LAS unsigned char*)(smem + 69632 + 2048 + 2560);
    unsigned char* cvl = smem + 98304;
    const int chunk = tid & 15, rg = tid >> 4;
#pragma unroll 1
    for (int uu = bid; uu < 256; uu += nblk) {
        const int unit = (uu & 7) * 32 + (uu >> 3);
        const int b = unit >> 5, g = (unit >> 2) & 7, s = unit & 3;
        const int c = g * 128 + s * 32 + r32;
        __syncthreads();
        if (tid < 128) {
#pragma unroll
            for (int k = 0; k < 4; ++k) cwl[k * 128 + tid] = p.in[I_LRU_CW][(size_t)(slot * 4 + k) * DM + g * 128 + tid];
            cwl[4 * 128 + tid] = p.in[I_LRU_CB][(size_t)slot * DM + g * 128 + tid];
        }
        if (tid < 64) {
            const bf16_t* wap = (const bf16_t*)(ws + WT_LRU_A) + ((size_t)(slot * 8 + g) * 128 + s * 32 + r32) * 128 + hi * 8;
            const bf16_t* wxp = (const bf16_t*)(ws + WT_LRU_X) + ((size_t)(slot * 8 + g) * 128 + s * 32 + r32) * 128 + hi * 8;
#pragma unroll
            for (int st = 0; st < 8; ++st) { *(LAS bf16x8*)(wfl + (st * 64 + lane) * 16) = *(const bf16x8*)(wap + st * 16); *(LAS bf16x8*)(wfl + ((8 + st) * 64 + lane) * 16) = *(const bf16x8*)(wxp + st * 16); }
        }
        const float ba = p.in[I_LRU_BA][(size_t)slot * DM + c], bx = p.in[I_LRU_BX][(size_t)slot * DM + c];
        const float ca = -8.0f * log1pf(__expf(-p.in[I_LRU_AP][(size_t)slot * DM + c]));
        const float L2E = 1.4426950408889634f, ba2 = -ba * L2E, bx2 = -bx * L2E, ca2 = ca * L2E;
        float hcar = 0.f;
        __syncthreads();
        const int cq0 = slot * 3 * CQ_PER_LAYER + unit * 8;
#pragma unroll 1
        for (int rt = 0; rt < 8; ++rt) {
            const int t0 = b * SEQ + rt * 256;
            u32x4 xr[11];
            {
                const bf16_t* xp = XBP + (size_t)(t0 + rg * 8 - 3) * DM + g * 128 + chunk * 8;
                const bool head = (rt == 0 && rg == 0);
#pragma unroll
                for (int i = 0; i < 11; ++i) { if (i < 3 && head) xr[i] = (u32x4){0u, 0u, 0u, 0u}; else xr[i] = *(const u32x4*)(xp + (size_t)i * DM); }
            }
            const int cq = cq0 + rt; const bool cvalid = true; CqJob CJ; f32x4 cv[8];
            if (cvalid) { convq_decode(p, cq, CJ);
#pragma unroll
                for (int i = 0; i < 8; ++i) cv[i] = __builtin_nontemporal_load((const f32x4*)(CJ.src + (size_t)(CJ.k0 + wid * 8 + i) * CJ.N + CJ.n0 + lane * 4)); }
            bf16_t ggv[16];
#pragma unroll
            for (int r = 0; r < 16; ++r) ggv[r] = GG[(size_t)(t0 + 32 * wid + crow(r, hi)) * DM + c];
            {
                f32x4 w0[4], w1[4];
#pragma unroll
                for (int k = 0; k < 4; ++k) { w0[k] = *(const LAS f32x4*)(cwl + k * 128 + chunk * 8); w1[k] = *(const LAS f32x4*)(cwl + k * 128 + chunk * 8 + 4); }
                const f32x4 bb0 = *(const LAS f32x4*)(cwl + 4 * 128 + chunk * 8), bb1 = *(const LAS f32x4*)(cwl + 4 * 128 + chunk * 8 + 4);
#pragma unroll
                for (int i = 0; i < 8; ++i) {
                    f32x4 o0 = bb0, o1 = bb1;
#pragma unroll
                    for (int k = 0; k < 4; ++k) {
                        const u32x4 x = xr[i + k];
                        f32x4 x0, x1;
                        x0[0] = __uint_as_float(x.x << 16); x0[1] = __uint_as_float(x.x & 0xffff0000u); x0[2] = __uint_as_float(x.y << 16); x0[3] = __uint_as_float(x.y & 0xffff0000u);
                        x1[0] = __uint_as_float(x.z << 16); x1[1] = __uint_as_float(x.z & 0xffff0000u); x1[2] = __uint_as_float(x.w << 16); x1[3] = __uint_as_float(x.w & 0xffff0000u);
                        o0 = o0 + x0 * w0[k]; o1 = o1 + x1 * w1[k];
                    }
                    *(LAS u32x4*)(Al + (rg * 8 + i) * 272 + chunk * 16) = g8::pack8(o0, o1);
                }
            }
            __syncthreads();
            f32x16 ar = {}, ax = {};
#pragma unroll
            for (int st = 0; st < 8; ++st) {
                const bf16x8 a = *(const LAS bf16x8*)(Al + (32 * wid + r32) * 272 + st * 32 + hi * 16);
                ar = __builtin_amdgcn_mfma_f32_32x32x16_bf16(a, *(const LAS bf16x8*)(wfl + (st * 64 + lane) * 16), ar, 0, 0, 0);
                ax = __builtin_amdgcn_mfma_f32_32x32x16_bf16(a, *(const LAS bf16x8*)(wfl + ((8 + st) * 64 + lane) * 16), ax, 0, 0, 0);
            }
            float av[16], bv[16];
#pragma unroll
            for (int r = 0; r < 16; ++r) {
                const float xb = bf2f(*(const LAS bf16_t*)(Al + (32 * wid + crow(r, hi)) * 272 + (s * 32 + r32) * 2));
                const float rgt = g8::fast_rcp(1.0f + __builtin_amdgcn_exp2f(__builtin_fmaf(ar[r], -L2E, ba2))), igt = g8::fast_rcp(1.0f + __builtin_amdgcn_exp2f(__builtin_fmaf(ax[r], -L2E, bx2)));
                const float a = __builtin_amdgcn_exp2f(ca2 * rgt);
                av[r] = a; bv[r] = __builtin_amdgcn_sqrtf(fmaxf(__builtin_fmaf(-a, a, 1.0f), 0.f)) * (igt * xb);
            }
            float GA[4], GB[4], PA[4], PB[4];
#pragma unroll
            for (int gi = 0; gi < 4; ++gi) {
                float A = av[4 * gi], Bq = bv[4 * gi];
#pragma unroll
                for (int k = 1; k < 4; ++k) { Bq = av[4 * gi + k] * Bq + bv[4 * gi + k]; A = av[4 * gi + k] * A; }
                GA[gi] = A; GB[gi] = Bq; PA[gi] = shx(A, 32, lane); PB[gi] = shx(Bq, 32, lane);
            }
            float TA = 1.f, TB = 0.f;
#pragma unroll
            for (int gi = 0; gi < 4; ++gi) {
                const float loA = hi ? PA[gi] : GA[gi], loB = hi ? PB[gi] : GB[gi], hiA = hi ? GA[gi] : PA[gi], hiB = hi ? GB[gi] : PB[gi];
                TB = loA * TB + loB; TA = loA * TA; TB = hiA * TB + hiB; TA = hiA * TA;
            }
            if (hi == 0) { wAB[(wid * 32 + r32) * 2] = TA; wAB[(wid * 32 + r32) * 2 + 1] = TB; }
            if (cvalid) {
#pragma unroll
                for (int i = 0; i < 4; ++i) {
                    f32x4 a, bq; a[0] = cv[0][i] * CJ.sc; a[1] = cv[1][i] * CJ.sc; a[2] = cv[2][i] * CJ.sc; a[3] = cv[3][i] * CJ.sc; bq[0] = cv[4][i] * CJ.sc; bq[1] = cv[5][i] * CJ.sc; bq[2] = cv[6][i] * CJ.sc; bq[3] = cv[7][i] * CJ.sc;
                    *(u32x2*)(cvl + (lane * 4 + i) * 72 + wid * 8) = g8::pack8_fp8(a, bq);
                }
            }
            __syncthreads();
            if (cvalid) {
#pragma unroll
                for (int q4 = 0; q4 < 2; ++q4) {
                    const int nn = q4 * 128 + (tid >> 2), ch = tid & 3;
                    u32x4 w; const u32x2 w0 = *(const u32x2*)(cvl + nn * 72 + ch * 16), w1 = *(const u32x2*)(cvl + nn * 72 + ch * 16 + 8); w.x = w0.x; w.y = w0.y; w.z = w1.x; w.w = w1.y;
                    *(u32x4*)(CJ.dst + (size_t)(CJ.n0 + nn) * 1024 + CJ.k0 + ch * 16) = w;
                }
            }
            float hin = hcar, hall = hcar;
#pragma unroll
            for (int w = 0; w < 8; ++w) {
                const float A = wAB[(w * 32 + r32) * 2], Bq = wAB[(w * 32 + r32) * 2 + 1];
                hall = A * hall + Bq; if (w < wid) hin = hall;
            }
            hcar = hall;
            float h = hin;
#pragma unroll
            for (int gi = 0; gi < 4; ++gi) {
                const float loA = hi ? PA[gi] : GA[gi], loB = hi ? PB[gi] : GB[gi], hiA = hi ? GA[gi] : PA[gi], hiB = hi ? GB[gi] : PB[gi];
                const float hlo = h, hhi = loA * h + loB;
                h = hiA * hhi + hiB;
                float hh = hi ? hhi : hlo;
#pragma unroll
                for (int k = 0; k < 4; ++k) {
                    hh = av[4 * gi + k] * hh + bv[4 * gi + k];
                    Y[(size_t)(t0 + 32 * wid + crow(4 * gi + k, hi)) * DM + c] = f2bf(hh * bf2f(ggv[4 * gi + k]));
                }
            }
        }
    }
}

__device__ __forceinline__ void phase_moe_route_fast(const Params& p, int layer, unsigned char* smem, int bid, int nblk) {
    const int tid = tid_opaque(), wid = __builtin_amdgcn_readfirstlane(tid >> 6), lane = tid & 63, r32 = lane & 31, hi = lane >> 5;
    unsigned char* ws = p.ws;
    const bf16_t* H = (const bf16_t*)(ws + WS_H); unsigned char* U8 = ws + WS_U8;
    const float* g = p.in[I_FFNN] + (size_t)layer * DM; const float* br = p.in[I_MOE_BR] + (size_t)layer * NE;
    const bf16_t* WrT = (const bf16_t*)(ws + WT_ROUTER) + (size_t)layer * NE * DM;
    int* cnt = (int*)(ws + WS_CTL) + CW_CNT + layer * NE; int* list = (int*)(ws + WS_LIST); int* tokslot = (int*)(ws + WS_TOKSLOT); float* gates = (float*)(ws + WS_GATES);
    LAS unsigned char* Ut = (LAS unsigned char*)smem;
    LAS float* part = (LAS float*)(smem + 66048);
    LAS float* lgt = (LAS float*)(smem + 66048 + 32768);
    LAS int* pick_e = (LAS int*)(smem + 66048 + 32768 + 8704);
    LAS int* pick_p = pick_e + 256;
    LAS float* pick_g = (LAS float*)(pick_p + 256);
    LAS int* lcnt = (LAS int*)(pick_g + 256);
#pragma unroll 1
    for (int uu = bid; uu < 256; uu += nblk) {
        const int base = (uu & 7) * 2048 + (uu >> 3) * 64;
        __syncthreads();
        if (tid < 32) lcnt[tid] = 0;
        bf16x8 bw[8];
#pragma unroll
        for (int st = 0; st < 8; ++st) bw[st] = *(const bf16x8*)(WrT + (size_t)r32 * DM + wid * 128 + st * 16 + hi * 8);
        f32x4 gg[4];
#pragma unroll
        for (int q = 0; q < 4; ++q) gg[q] = *(const f32x4*)(g + q * 256 + lane * 4);
        u32x2 hw[4][4], hn[4][4];
#pragma unroll
        for (int j = 0; j < 4; ++j)
#pragma unroll
            for (int q = 0; q < 4; ++q) hw[j][q] = *(const u32x2*)(H + (size_t)(base + wid * 4 + j) * DM + q * 256 + lane * 4);
#pragma unroll
        for (int pass = 0; pass < 2; ++pass) {
            const int tok0 = base + pass * 32;
            if (pass == 0) {
#pragma unroll
                for (int j = 0; j < 4; ++j)
#pragma unroll
                    for (int q = 0; q < 4; ++q) hn[j][q] = *(const u32x2*)(H + (size_t)(base + 32 + wid * 4 + j) * DM + q * 256 + lane * 4);
            }
#pragma unroll
            for (int j = 0; j < 4; ++j) {
                const int row = wid * 4 + j;
                f32x4 v[4]; float ss = 0.f;
#pragma unroll
                for (int q = 0; q < 4; ++q) { const u32x2 w = hw[j][q];
                    v[q][0] = __uint_as_float(w.x << 16); v[q][1] = __uint_as_float(w.x & 0xffff0000u); v[q][2] = __uint_as_float(w.y << 16); v[q][3] = __uint_as_float(w.y & 0xffff0000u);
                    ss += v[q][0] * v[q][0] + v[q][1] * v[q][1] + v[q][2] * v[q][2] + v[q][3] * v[q][3]; }
                ss = wave_sum(ss, lane);
                const float rstd = rsqrtf(ss * (1.0f / 1024.0f) + RMS_EPS);
#pragma unroll
                for (int q = 0; q < 4; ++q) {
                    f32x4 un; un[0] = v[q][0] * rstd * gg[q][0]; un[1] = v[q][1] * rstd * gg[q][1]; un[2] = v[q][2] * rstd * gg[q][2]; un[3] = v[q][3] * rstd * gg[q][3];
                    u32x2 w; w.x = pk2(un[0], un[1]); w.y = pk2(un[2], un[3]);
                    *(LAS u32x2*)(Ut + row * 2064 + (q * 256 + lane * 4) * 2) = w;
                    int w8 = 0; w8 = __builtin_amdgcn_cvt_pk_fp8_f32(g8::clamp448(un[0]), g8::clamp448(un[1]), w8, false); w8 = __builtin_amdgcn_cvt_pk_fp8_f32(g8::clamp448(un[2]), g8::clamp448(un[3]), w8, true);
                    *(int*)(U8 + (size_t)(tok0 + row) * DM + q * 256 + lane * 4) = w8;
                }
            }
            __syncthreads();
            f32x16 acc = {};
#pragma unroll
            for (int st = 0; st < 8; ++st) {
                const int k = wid * 128 + st * 16 + hi * 8;
                const bf16x8 a = *(const LAS bf16x8*)(Ut + r32 * 2064 + k * 2);
                acc = __builtin_amdgcn_mfma_f32_32x32x16_bf16(a, bw[st], acc, 0, 0, 0);
            }
#pragma unroll
            for (int r = 0; r < 16; ++r) part[(wid * 16 + r) * 64 + lane] = acc[r];
            __syncthreads();
#pragma unroll
            for (int o2 = 0; o2 < 2; ++o2) {
                const int o = tid + o2 * 512, r = o >> 6, l = o & 63;
                float s = 0.f;
#pragma unroll
                for (int w = 0; w < 8; ++w) s += part[(w * 16 + r) * 64 + l];
                lgt[pass * 1088 + crow(r, l >> 5) * 33 + (l & 31)] = s + br[l & 31];
            }
            if (pass == 0) {
#pragma unroll
                for (int j = 0; j < 4; ++j)
#pragma unroll
                    for (int q = 0; q < 4; ++q) hw[j][q] = hn[j][q];
            }
        }
        __syncthreads();
        if (tid < 64) {
            float lg[NE];
#pragma unroll
            for (int e = 0; e < NE; ++e) lg[e] = lgt[(tid >> 5) * 1088 + (tid & 31) * 33 + e];
            unsigned used = 0u; float bv[4]; int bi[4];
#pragma unroll
            for (int k = 0; k < TOPK; ++k) {
                float best = -INFINITY; int idx = 0;
#pragma unroll
                for (int e = 0; e < NE; ++e) { const bool ok = !((used >> e) & 1u) && (lg[e] > best); best = ok ? lg[e] : best; idx = ok ? e : idx; }
                used |= 1u << idx; bv[k] = best; bi[k] = idx;
            }
            float w[4], wsum = 0.f;
#pragma unroll
            for (int k = 0; k < TOPK; ++k) { w[k] = __expf(bv[k] - bv[0]); wsum += w[k]; }
            const float inv = 1.0f / wsum;
#pragma unroll
            for (int k = 0; k < TOPK; ++k) {
                const int slot = tid * 4 + k;
                pick_e[slot] = bi[k]; pick_g[slot] = w[k] * inv;
                pick_p[slot] = __hip_atomic_fetch_add(&lcnt[bi[k]], 1, __ATOMIC_RELAXED, __HIP_MEMORY_SCOPE_WORKGROUP);
            }
        }
        __syncthreads();
        if (tid < 32) { const int n = lcnt[tid]; lcnt[32 + tid] = n ? atomicAdd(&cnt[tid], n) : 0; }
        __syncthreads();
        if (tid < 256) {
            const int tl = tid >> 2, e = pick_e[tid], pos = lcnt[32 + e] + pick_p[tid], t = base + tl;
            list[e * ECAP + pos] = t; tokslot[t * 4 + (tid & 3)] = (e << 16) | pos; gates[t * 4 + (tid & 3)] = pick_g[tid];
        }
    }
}

__device__ __forceinline__ void phase_moe_comb_fast(const Params& p, int layer, unsigned char* smem, int bid, int nblk) {
    const int tid = tid_opaque(), wid = __builtin_amdgcn_readfirstlane(tid >> 6), lane = tid & 63;
    unsigned char* ws = p.ws;
    const int* cnt = (const int*)(ws + WS_CTL) + CW_CNT + layer * NE;
    LAS const int* ps = (LAS const int*)(smem + g8::STAGE_BYTES + LDS_MISC_OFF) + g8::MOE_TAB_PS;
    bf16_t* H = (bf16_t*)(ws + WS_H); unsigned char* U = ws + WS_U; const unsigned char* YS = ws + WS_YS;
    const int* tokslot = (const int*)(ws + WS_TOKSLOT); const float* gates = (const float*)(ws + WS_GATES);
    const bool last = (layer == 3);
    const float* g = last ? p.in[I_FINN] : p.in[I_MIXN] + (size_t)(layer + 1) * DM;
    f32x4 gg[2][2];
#pragma unroll
    for (int sg = 0; sg < 2; ++sg) { gg[sg][0] = *(const f32x4*)(g + sg * 512 + lane * 8); gg[sg][1] = *(const f32x4*)(g + sg * 512 + lane * 8 + 4); }
    auto tok_at = [&](int q) __attribute__((always_inline)) { const int uu = bid + (q >> 2) * nblk; return uu < 256 ? (uu & 7) * 2048 + (uu >> 3) * 64 + (q & 3) * 16 + wid * 2 : -1; };
    int slv = 0; float gwv = 0.f;
    { const int tf = tok_at(0); if (tf >= 0) { slv = tokslot[tf * 4 + (lane & 7)]; gwv = gates[tf * 4 + (lane & 7)]; } }
#pragma unroll 1
    for (int q = 0; ; ++q) {
        const int t0 = tok_at(q); if (t0 < 0) break;
        f32x4 v[2][2][2]; u32x2 y[2][4][2]; float gw[2][4];
        const int slc = slv; const float gwc = gwv;
        { const int tn = tok_at(q + 1); if (tn >= 0) { slv = tokslot[tn * 4 + (lane & 7)]; gwv = gates[tn * 4 + (lane & 7)]; } }
#pragma unroll
        for (int a = 0; a < 2; ++a) {
            const int t = t0 + a;
            const bf16_t* hrow = H + (size_t)t * DM;
#pragma unroll
            for (int sg = 0; sg < 2; ++sg) { const u32x4 w = *(const u32x4*)(hrow + sg * 512 + lane * 8);
                v[a][sg][0][0] = __uint_as_float(w.x << 16); v[a][sg][0][1] = __uint_as_float(w.x & 0xffff0000u); v[a][sg][0][2] = __uint_as_float(w.y << 16); v[a][sg][0][3] = __uint_as_float(w.y & 0xffff0000u);
                v[a][sg][1][0] = __uint_as_float(w.z << 16); v[a][sg][1][1] = __uint_as_float(w.z & 0xffff0000u); v[a][sg][1][2] = __uint_as_float(w.w << 16); v[a][sg][1][3] = __uint_as_float(w.w & 0xffff0000u); }
#pragma unroll
            for (int k = 0; k < TOPK; ++k) {
                const int sl = __builtin_amdgcn_readlane(slc, a * 4 + k); gw[a][k] = __int_as_float(__builtin_amdgcn_readlane(__float_as_int(gwc), a * 4 + k)) * 0.0625f;
                const unsigned char* yr = YS + (size_t)(ps[sl >> 16] + (sl & 0xffff)) * DM;
#pragma unroll
                for (int sg = 0; sg < 2; ++sg) y[a][k][sg] = __builtin_nontemporal_load((const u32x2*)(yr + sg * 512 + lane * 8));
            }
        }
#pragma unroll
        for (int a = 0; a < 2; ++a) {
            const int t = t0 + a;
            float ss = 0.f;
#pragma unroll
            for (int sg = 0; sg < 2; ++sg) {
#pragma unroll
                for (int k = 0; k < TOPK; ++k) {
                    const u32x2 w = y[a][k][sg]; const float q = gw[a][k];
                    const f32x2_t p0 = __builtin_amdgcn_cvt_pk_f32_fp8((int)w.x, false), p1 = __builtin_amdgcn_cvt_pk_f32_fp8((int)w.x, true);
                    const f32x2_t p2 = __builtin_amdgcn_cvt_pk_f32_fp8((int)w.y, false), p3 = __builtin_amdgcn_cvt_pk_f32_fp8((int)w.y, true);
                    v[a][sg][0][0] += q * p0[0]; v[a][sg][0][1] += q * p0[1]; v[a][sg][0][2] += q * p1[0]; v[a][sg][0][3] += q * p1[1];
                    v[a][sg][1][0] += q * p2[0]; v[a][sg][1][1] += q * p2[1]; v[a][sg][1][2] += q * p3[0]; v[a][sg][1][3] += q * p3[1];
                }
#pragma unroll
                for (int hh = 0; hh < 2; ++hh)
#pragma unroll
                    for (int j = 0; j < 4; ++j) ss += v[a][sg][hh][j] * v[a][sg][hh][j];
            }
            ss = wave_sum(ss, lane);
            const float rstd = rsqrtf(ss * (1.0f / 1024.0f) + RMS_EPS);
#pragma unroll
            for (int sg = 0; sg < 2; ++sg) {
                const f32x4 o0 = v[a][sg][0] * rstd * gg[sg][0], o1 = v[a][sg][1] * rstd * gg[sg][1];
                if (last) {
                    *(f32x4*)(p.out + (size_t)t * DM + sg * 512 + lane * 8) = o0; *(f32x4*)(p.out + (size_t)t * DM + sg * 512 + lane * 8 + 4) = o1;
                } else {
                    *(u32x4*)(H + (size_t)t * DM + sg * 512 + lane * 8) = g8::pack8(v[a][sg][0], v[a][sg][1]);
                    *(u32x2*)(U + (size_t)t * DM + sg * 512 + lane * 8) = g8::pack8_fp8(o0, o1);
                }
            }
        }
    }
}

__device__ __forceinline__ void phase_sb_attn_fast(const Params& p, int bid, int nblk) {
    const int tid = tid_opaque(), wid = __builtin_amdgcn_readfirstlane(tid >> 6), lane = tid & 63, r32 = lane & 31, hi = lane >> 5;
    unsigned char* ws = p.ws;
    const bf16_t* Q = (const bf16_t*)(ws + WS_B0); const bf16_t* Kp = (const bf16_t*)(ws + WS_B1); const bf16_t* V = (const bf16_t*)(ws + WS_B2); bf16_t* O = (bf16_t*)(ws + WS_B3);
#pragma unroll 1
    for (int uu = bid; uu < 256; uu += nblk)
#pragma unroll 1
    for (int k4 = 0; k4 < 4; ++k4) {
        const int unit = (uu & 7) * 1024 + k4 * 256 + (uu >> 3) * 8 + wid;
        const int qb = unit & 63, h = (unit >> 6) & 15, b = unit >> 10;
        const int q0 = qb * 32; const size_t tb = (size_t)b * SEQ;
        bf16x8 qf[4];
#pragma unroll
        for (int st = 0; st < 4; ++st) qf[st] = *(const bf16x8*)(Q + (tb + q0 + r32) * DM + h * HD + st * 16 + hi * 8);
        f32x16 o0 = {}, o1 = {};
        float carry = 1.0f;
        bf16x8 kf[4];
        {
            const bf16_t* kp = Kp + (tb + q0 + r32) * DM + h * HD + hi * 8;
#pragma unroll
            for (int st = 0; st < 4; ++st) kf[st] = *(const bf16x8*)(kp + st * 16);
        }
#pragma unroll 1
        for (int kt = qb; kt >= 0; --kt) {
            const int kbase = kt * 32;
            bf16x8 vf[2][2];
            {
                const bf16_t* vp = V + (tb + kbase + 4 * hi) * DM + h * HD + r32;
#pragma unroll
                for (int s = 0; s < 2; ++s)
#pragma unroll
                    for (int d0 = 0; d0 < 2; ++d0)
#pragma unroll
                        for (int j = 0; j < 8; ++j) vf[s][d0][j] = (short)vp[(size_t)(16 * s + 8 * (j >> 2) + (j & 3)) * DM + d0 * 32];
            }
            f32x16 sc = {};
#pragma unroll
            for (int st = 0; st < 4; ++st) sc = __builtin_amdgcn_mfma_f32_32x32x16_bf16(kf[st], qf[st], sc, 0, 0, 0);
            if (kt > 0) {
                const bf16_t* kp = Kp + (tb + kbase - 32 + r32) * DM + h * HD + hi * 8;
#pragma unroll
                for (int st = 0; st < 4; ++st) kf[st] = *(const bf16x8*)(kp + st * 16);
            }
            float rr[16];
#pragma unroll
            for (int r = 0; r < 16; ++r) {
                const float e = __builtin_amdgcn_exp2f(sc[r]);
                float x = __builtin_amdgcn_rcpf(1.0f + e);
                if (kt == qb) x = (crow(r, hi) < r32) ? x : 1.0f;
                rr[r] = x;
            }
            float G[4], P[4];
#pragma unroll
            for (int gi = 0; gi < 4; ++gi) { G[gi] = (rr[4 * gi] * rr[4 * gi + 1]) * (rr[4 * gi + 2] * rr[4 * gi + 3]); P[gi] = shx(G[gi], 32, lane); }
            float cur = carry, av[16];
#pragma unroll
            for (int gi = 3; gi >= 0; --gi) {
                const float hiP = hi ? G[gi] : P[gi], loP = hi ? P[gi] : G[gi];
                const float ent_hi = cur; cur *= hiP; const float ent_lo = cur; cur *= loP;
                float s_cur = hi ? ent_hi : ent_lo;
#pragma unroll
                for (int k = 3; k >= 0; --k) { const float s_next = s_cur * rr[4 * gi + k]; av[4 * gi + k] = s_cur - s_next; s_cur = s_next; }
            }
            carry = cur;
            bf16x8 pf[2];
#pragma unroll
            for (int s = 0; s < 2; ++s) {
                u32x4 w; w.x = pk2(av[8 * s], av[8 * s + 1]); w.y = pk2(av[8 * s + 2], av[8 * s + 3]); w.z = pk2(av[8 * s + 4], av[8 * s + 5]); w.w = pk2(av[8 * s + 6], av[8 * s + 7]);
                pf[s] = __builtin_bit_cast(bf16x8, w);
            }
            o0 = __builtin_amdgcn_mfma_f32_32x32x16_bf16(pf[0], vf[0][0], o0, 0, 0, 0);
            o1 = __builtin_amdgcn_mfma_f32_32x32x16_bf16(pf[0], vf[0][1], o1, 0, 0, 0);
            o0 = __builtin_amdgcn_mfma_f32_32x32x16_bf16(pf[1], vf[1][0], o0, 0, 0, 0);
            o1 = __builtin_amdgcn_mfma_f32_32x32x16_bf16(pf[1], vf[1][1], o1, 0, 0, 0);
            if (__all(carry == 0.0f)) break;
        }
#pragma unroll
        for (int r = 0; r < 16; ++r) {
            bf16_t* op = O + (tb + q0 + crow(r, hi)) * DM + h * HD + r32;
            op[0] = f2bf(o0[r]); op[32] = f2bf(o1[r]);
        }
    }
}

__device__ __forceinline__ void unpack8(const u32x4& x, float (&f)[8]) {
    f[0] = __uint_as_float(x.x << 16); f[1] = __uint_as_float(x.x & 0xffff0000u); f[2] = __uint_as_float(x.y << 16); f[3] = __uint_as_float(x.y & 0xffff0000u);
    f[4] = __uint_as_float(x.z << 16); f[5] = __uint_as_float(x.z & 0xffff0000u); f[6] = __uint_as_float(x.w << 16); f[7] = __uint_as_float(x.w & 0xffff0000u);
}
template <int WIN>
__device__ __forceinline__ void pool_tile_w(const Params& p, int pm, int g) {
    const int tid = tid_opaque();
    unsigned char* ws = p.ws;
    const bf16_t* v = (const bf16_t*)(ws + WS_B0); bf16_t* pb = (bf16_t*)(ws + WS_B1);
    const int chunk = tid & 31, rb = tid >> 5;
    const int c0 = g * 256 + chunk * 8;
#pragma unroll 1
    for (int half = 0; half < 2; ++half) {
        const int t0 = pm * 256 + rb * 16 + half * 8, pos0 = t0 & (SEQ - 1);
        u32x4 rows[WIN - 1 + 8];
#pragma unroll
        for (int i = 0; i < WIN - 1 + 8; ++i) {
            const int d = i - (WIN - 1);
            if (pos0 + d >= 0) rows[i] = *(const u32x4*)(v + (size_t)(t0 + d) * DM + c0); else rows[i] = (u32x4){0u, 0u, 0u, 0u};
        }
        float s[8];
#pragma unroll
        for (int j = 0; j < 8; ++j) s[j] = 0.f;
#pragma unroll
        for (int i = 0; i < WIN - 1; ++i) { float f[8]; unpack8(rows[i], f);
#pragma unroll
            for (int j = 0; j < 8; ++j) s[j] += f[j]; }
#pragma unroll
        for (int i = 0; i < 8; ++i) {
            const int pos = pos0 + i;
            float xv[8]; unpack8(rows[WIN - 1 + i], xv);
#pragma unroll
            for (int j = 0; j < 8; ++j) s[j] += xv[j];
            const int n = pos + 1 < WIN ? pos + 1 : WIN; const float inv = g8::fast_rcp((float)n); const float inv2 = inv * (2.0f - (float)n * inv);
            f32x4 o0, o1;
#pragma unroll
            for (int j = 0; j < 4; ++j) { o0[j] = s[j] * inv2 - xv[j]; o1[j] = s[4 + j] * inv2 - xv[4 + j]; }
            *(u32x4*)(pb + (size_t)(t0 + i) * DM + c0) = g8::pack8(o0, o1);
            float lv[8]; unpack8(rows[i], lv);
#pragma unroll
            for (int j = 0; j < 8; ++j) s[j] -= lv[j];
        }
    }
    asm volatile("s_waitcnt vmcnt(0)" ::: "memory");
    __syncthreads();
}
__device__ __forceinline__ void pool_tile(const Params& p, int pm, int g) {
    if (g == 0) pool_tile_w<2>(p, pm, g); else if (g == 1) pool_tile_w<4>(p, pm, g); else if (g == 2) pool_tile_w<8>(p, pm, g); else pool_tile_w<16>(p, pm, g);
}

__device__ __forceinline__ unsigned char* opq(unsigned char* q) {
    const unsigned long long v = (unsigned long long)q;
    unsigned lo = (unsigned)__builtin_amdgcn_readfirstlane((int)(unsigned)v), hi = (unsigned)__builtin_amdgcn_readfirstlane((int)(unsigned)(v >> 32));
    asm volatile("" : "+s"(lo), "+s"(hi));
    return (unsigned char*)(((unsigned long long)hi << 32) | lo);
}
#define XB_TMO      128
#define XB_XCNT(j)  (256  + 64 * (j))
#define XB_XSUB(j)  (1280 + 64 * (j))
#define XB_XGEN(j)  (2304 + 64 * (j))
#define XB_TOP      3328
#define XB_TOPGEN   3392
#define XCD_BAR_WORDS 3456
#define XB_SPIN_CAP (1u << 21)
__device__ __forceinline__ unsigned xb_ld(unsigned* p)              { return __hip_atomic_load(p, __ATOMIC_RELAXED, __HIP_MEMORY_SCOPE_AGENT); }
__device__ __forceinline__ unsigned xb_add(unsigned* p, unsigned v) { return __hip_atomic_fetch_add(p, v, __ATOMIC_RELAXED, __HIP_MEMORY_SCOPE_AGENT); }
__device__ __forceinline__ unsigned xb_xcc_id() { return (unsigned)__builtin_amdgcn_s_getreg((3 << 11) | 20) & 0xFu; }
#define XB_SPIN(cond, bar) do { unsigned _sp = 0; while (cond) { __builtin_amdgcn_s_sleep(1); \
    if ((++_sp & 255u) == 0u) { if (xb_ld(&(bar)[XB_TMO])) break; if (_sp > XB_SPIN_CAP) { atomicAdd(&(bar)[XB_TMO], 1u); break; } } } } while (0)
struct XcdBarrier { unsigned* bar; unsigned x; volatile LAS unsigned* st; };
__device__ __forceinline__ XcdBarrier xcd_barrier_post(unsigned* bar, volatile LAS unsigned* st) {
    XcdBarrier b; b.bar = bar; b.x = xb_xcc_id(); b.st = st;
    if (threadIdx.x == 0) st[3] = xb_add(&bar[XB_XCNT(b.x)], 1u);
    return b;
}
__device__ __forceinline__ void xcd_barrier_complete(unsigned* bar, unsigned x, unsigned& nloc, unsigned& nx, unsigned& even) {
    const unsigned G = gridDim.x * gridDim.y * gridDim.z;
    unsigned sum, cnt, mine, c32, sp = 0u;
    for (;;) {
        sum = 0u; cnt = 0u; mine = 0u; c32 = 0u;
#pragma unroll
        for (unsigned j = 0; j < 16; ++j) { const unsigned c = xb_ld(&bar[XB_XCNT(j)]); sum += c; cnt += (c > 0u) ? 1u : 0u; mine = (j == x) ? c : mine; c32 += (j < 8u && c == 32u) ? 1u : 0u; }
        if (sum == G) break;
        __builtin_amdgcn_s_sleep(1);
        if ((++sp & 255u) == 0u) { if (xb_ld(&bar[XB_TMO])) break; if (sp > XB_SPIN_CAP) { atomicAdd(&bar[XB_TMO], 1u); break; } }
    }
    nloc = mine > 0u ? mine : 1u; nx = cnt > 0u ? cnt : 1u; even = (c32 == 8u && sum == 256u) ? 1u : 0u;
}
__device__ __forceinline__ void xcd_barrier(unsigned char* wsb, unsigned char* smem, bool local = false) {
    asm volatile("s_waitcnt vmcnt(0)" ::: "memory");
    __syncthreads();
    if (tid_opaque() == 0) {
        unsigned* bar = (unsigned*)opq(wsb + WS_CTL);
        volatile LAS unsigned* st = (volatile LAS unsigned*)(smem + g8::STAGE_BYTES);
        unsigned bx = xb_xcc_id(); asm volatile("" : "+s"(bx));
        __builtin_amdgcn_s_waitcnt(0);
        unsigned nloc = st[0], nx = st[1];
        if (nloc == 0u) { unsigned even; xcd_barrier_complete(bar, bx, nloc, nx, even); st[0] = nloc; st[1] = nx; st[2] = even; }
        const unsigned old = xb_add(&bar[XB_XSUB(bx)], 1u);
        const unsigned gen = old / nloc;
        if (old + 1u == (gen + 1u) * nloc) {
            if (!local) {
                __builtin_amdgcn_fence(__ATOMIC_RELEASE, "agent");
                asm volatile("s_waitcnt vmcnt(0)" ::: "memory");
                const unsigned og = xb_add(&bar[XB_TOP], 1u);
                const unsigned tg = og / nx;
                if (og + 1u == (tg + 1u) * nx) xb_add(&bar[XB_TOPGEN], 1u);
                else XB_SPIN(xb_ld(&bar[XB_TOPGEN]) == tg, bar);
            }
            __builtin_amdgcn_fence(__ATOMIC_ACQUIRE, "agent");
            xb_add(&bar[XB_XGEN(bx)], 1u);
            asm volatile("s_waitcnt vmcnt(0)" ::: "memory");
        } else {
            XB_SPIN(xb_ld(&bar[XB_XGEN(bx)]) == gen, bar);
            __builtin_amdgcn_fence(__ATOMIC_ACQUIRE, "agent");
            asm volatile("s_waitcnt vmcnt(0)" ::: "memory");
        }
    }
    __syncthreads();
}

constexpr int LDS_BYTES = 147456;
constexpr int LDS_MISC = 64 + 1024 + 10240;

__global__ void __launch_bounds__(512, 2) mega_fwd(Params p) {
    extern __shared__ __attribute__((aligned(16))) unsigned char smem[];
    if ((threadIdx.x & 63) == 0) *(volatile LAS unsigned*)(LDS_WTAB + (threadIdx.x >> 6) * 4u) = hw_slot_id();
    if (threadIdx.x == 0) *(u32x4*)(smem + g8::STAGE_BYTES) = (u32x4){0u, 0u, 0u, 0u};
    __syncthreads();
    (void)xcd_barrier_post((unsigned*)(p.ws + WS_CTL), (volatile LAS unsigned*)(smem + g8::STAGE_BYTES));
    int bid = blockIdx.x; const int nblk = gridDim.x; bool xl = false;
#define GRID_BAR() xcd_barrier(p.ws, smem)
#define SEAM_BAR() xcd_barrier(p.ws, smem, xl)
#define RING ((LAS unsigned char*)smem)
#define WSB(off) ((bf16_t*)(ws + (off)))
    phase_prep(p, smem, bid, nblk);
    GRID_BAR();
    { volatile LAS unsigned* st = (volatile LAS unsigned*)(smem + g8::STAGE_BYTES);
      const unsigned even = (unsigned)__builtin_amdgcn_readfirstlane((int)st[2]), rk = (unsigned)__builtin_amdgcn_readfirstlane((int)st[3]);
      xl = (even != 0u) && (nblk == 256);
      if (xl) bid = (int)(rk * 8u + xb_xcc_id()); }
#pragma unroll 1
    for (int layer = 0; layer < 4; ++layer) {
        const int kind = layer % 3, slot = layer / 3;
        const bool cfirst = xl && (bid & 1);
#define CONV_LAYER() do { const int tb = (layer % 3 == 0) ? 2048 : 0; int done = ((const int*)(p.ws + WS_CTL))[CW_QHEAD + layer]; done = __builtin_amdgcn_readfirstlane(done); done = done < CQ_PER_LAYER - tb ? done : CQ_PER_LAYER - tb; \
          conv_range(p, smem, layer * CQ_PER_LAYER + tb + done, (layer + 1) * CQ_PER_LAYER, bid, nblk); } while (0)
#pragma unroll 1
        for (int cstep = 0; cstep < 2; ++cstep) {
        if (cstep == (cfirst ? 0 : 1)) CONV_LAYER();
        if (cstep == 0) {
        if (kind == 0) {
            { unsigned char* ws = opq(p.ws);
              g8::DenseSched S; S.init(T_TOK, 2048, nblk, bid, DM, (const unsigned char*)(ws + WT_LRU_IN) + (size_t)slot * 2048 * 1024, DM, 0);
              g8::gemm_phase<g8::DenseSched, g8::EpiB<1>, 1>(RING, (const char*)(ws + WS_U), DM, DM / 128, S, g8::EpiB<1>{WSB(WS_B0), WSB(WS_B1), nullptr, nullptr, 0.f, DM, 0}, 0x7A7A7A7A); }
            SEAM_BAR();
            phase_lru_mid(p, slot, smem, bid, nblk);
            SEAM_BAR();
            { unsigned char* ws = opq(p.ws); const float* hin = (layer == 0) ? p.in[I_X] : nullptr;
              g8::DenseSched S; S.init(T_TOK, 1024, nblk, bid, DM * 2, WSB(WT_LRU_OUT) + (size_t)slot * 1024 * 1024, DM * 2, 0);
              g8::gemm_phase(RING, (const char*)WSB(WS_B3), DM * 2, DM / 64, S, g8::EpiRes{hin, WSB(WS_H), WSB(WS_H)}); }
            SEAM_BAR();
        } else if (kind == 1) {
            { unsigned char* ws = opq(p.ws);
              g8::DenseSched S; S.init(T_TOK, 1024, nblk, bid, DM, (const unsigned char*)(ws + WT_POOL_IN), DM, 0);
              g8::gemm_phase<g8::DenseSched, g8::EpiB<0>, 1>(RING, (const char*)(ws + WS_U), DM, DM / 128, S, g8::EpiB<0>{WSB(WS_B0), nullptr, nullptr, nullptr, 0.f, DM, 0}, 0x7A7A7A7A); }
            SEAM_BAR();
            { unsigned char* ws = opq(p.ws);
              for (int uu = bid; uu < 256; uu += nblk) { const int L = (uu & 7) * 32 + (uu >> 3); pool_tile(p, L >> 2, L & 3); }
              g8::PoolGrpSched S; S.G = nblk; S.c = bid; S.Wg = (const char*)(ws + WT_POOL_G);
              g8::gemm_phase(RING, (const char*)WSB(WS_B1), 256 * 2, 256 / 64, S, g8::EpiB<3>{WSB(WS_B2), nullptr, nullptr, p.in[I_POOL_SC], 0.f, DM, 0}); }
            SEAM_BAR();
            { unsigned char* ws = opq(p.ws); const float* hin = nullptr;
              g8::DenseSched S; S.init(T_TOK, 1024, nblk, bid, DM * 2, WSB(WT_POOL_OUT), DM * 2, 0);
              g8::gemm_phase(RING, (const char*)WSB(WS_B2), DM * 2, DM / 64, S, g8::EpiRes{hin, WSB(WS_H), WSB(WS_H)}); }
            SEAM_BAR();
        } else {
            { unsigned char* ws = opq(p.ws);
              g8::DenseSched S; S.init(T_TOK, 3072, nblk, bid, DM, (const unsigned char*)(ws + WT_QKV), DM, 0);
              g8::gemm_phase<g8::DenseSched, g8::EpiB<2>, 1>(RING, (const char*)(ws + WS_U), DM, DM / 128, S, g8::EpiB<2>{WSB(WS_B0), WSB(WS_B1), WSB(WS_B2), nullptr, 0.125f * 1.4426950408889634f, DM, 0}, 0x7A7A7A7A); }
            SEAM_BAR();
            phase_sb_attn_fast(p, bid, nblk);
            SEAM_BAR();
            { unsigned char* ws = opq(p.ws); const float* hin = nullptr;
              g8::DenseSched S; S.init(T_TOK, 1024, nblk, bid, DM * 2, WSB(WT_SB_OUT), DM * 2, 0);
              g8::gemm_phase(RING, (const char*)WSB(WS_B3), DM * 2, DM / 64, S, g8::EpiRes{hin, WSB(WS_H), WSB(WS_H)}); }
            SEAM_BAR();
        }
        phase_moe_route_fast(p, layer, smem, bid, nblk);
        } }
        GRID_BAR();
        phase_moe_gemm_fast<1>(p, layer, smem, bid, nblk, xl);
        SEAM_BAR();
        phase_moe_gemm_fast<0>(p, layer, smem, bid, nblk, xl);
        GRID_BAR();
        phase_moe_comb_fast(p, layer, smem, bid, nblk);
        if (layer < 3) SEAM_BAR();
    }
#undef GRID_BAR
#undef SEAM_BAR
#undef CONV_LAYER
}

extern "C" void kernel_launch(void* const* d_in, const int* in_sizes, int n_in, void* d_out, int out_size, void* d_ws, size_t ws_size, hipStream_t stream) {
    Params p{};
    for (int i = 0; i < 25; ++i) p.in[i] = (const float*)d_in[i];
    p.out = (float*)d_out; p.ws = (unsigned char*)d_ws;
    static int grid = 0;
    if (!grid) {
        int dev = 0, cus = 0, per_cu = 0;
        (void)hipGetDevice(&dev);
        (void)hipDeviceGetAttribute(&cus, hipDeviceAttributeMultiprocessorCount, dev);
        (void)hipFuncSetAttribute((const void*)mega_fwd, hipFuncAttributeMaxDynamicSharedMemorySize, LDS_BYTES);
        (void)hipOccupancyMaxActiveBlocksPerMultiprocessor(&per_cu, (const void*)mega_fwd, 512, LDS_BYTES);
        grid = cus * (per_cu < 1 ? per_cu : 1);
        if (grid <= 0) grid = 1;
    }
    (void)hipMemsetAsync(d_ws, 0, 1 * MB, stream);
    hipLaunchKernelGGL(mega_fwd, dim3(grid), dim3(512), LDS_BYTES, stream, p);
}
```
